# Optimizing an MI355X kernel written in HIP

```python
import math
import jax, jax.numpy as jnp
from jax import lax
import numpy as np

D_MODEL = 1024
BATCH = 8
SEQ = 4096
DEPTH = 2

HEAD_DIM = 64
N_HEADS = D_MODEL // HEAD_DIM
N_HEADS_DIL = (3 * N_HEADS) // 4
N_HEADS_FOX = N_HEADS - N_HEADS_DIL
D_DIL = N_HEADS_DIL * HEAD_DIM
D_FOX = N_HEADS_FOX * HEAD_DIM
D_MIX = D_DIL + D_FOX
D_PROJ = 3 * D_DIL + 3 * D_FOX + N_HEADS_FOX
DILATED_PATTERNS = ((128, 1), (512, 4), (2048, 16))
BLOCK = 128
ROPE_THETA = 10000.0
N_EXPERTS = 16
N_GROUPS = 4
EXPERTS_PER_GROUP = N_EXPERTS // N_GROUPS
TOP_K = 2
D_FF_EXPERT = D_MODEL
DEEPNORM_ALPHA = (2.0 * DEPTH) ** 0.25
DEEPNORM_BETA = (8.0 * DEPTH) ** -0.25
LN_EPS = 1e-5
RMS_EPS = 1e-6

kernel_name = 'hymba_longnet_fox_grouped_moe_deepnorm'


def layer_norm(x, g, b):
    xf = x.astype(jnp.float32)
    mu = jnp.mean(xf, axis=-1, keepdims=True)
    var = jnp.mean(jnp.square(xf - mu), axis=-1, keepdims=True)
    return ((xf - mu) * lax.rsqrt(var + LN_EPS) * g + b).astype(x.dtype)


def rms_norm(x, g):
    xf = x.astype(jnp.float32)
    ms = jnp.mean(jnp.square(xf), axis=-1, keepdims=True)
    return (xf * lax.rsqrt(ms + RMS_EPS) * g).astype(x.dtype)


def rope(t, pos):
    half = HEAD_DIM // 2
    inv = ROPE_THETA ** (-jnp.arange(half, dtype=jnp.float32) / half)
    ang = pos[:, None] * inv[None, :]
    cos, sin = jnp.cos(ang), jnp.sin(ang)
    t1 = t[..., :half].astype(jnp.float32)
    t2 = t[..., half:].astype(jnp.float32)
    return jnp.concatenate([t1 * cos - t2 * sin, t2 * cos + t1 * sin], axis=-1).astype(t.dtype)


def dilated_branch(q, k, v, window, dil):
    B, H, S, hd = q.shape
    L = S // dil
    steps = window // dil
    nb = -(-L // BLOCK)
    Lp = nb * BLOCK

    def fold(t):
        t = t.reshape(B, H, L, dil, hd).transpose(0, 1, 3, 2, 4)
        t = jnp.pad(t, ((0, 0), (0, 0), (0, 0), (0, Lp - L), (0, 0)))
        return t.reshape(B, H, dil, nb, BLOCK, hd)

    def with_prev(t):
        prev = jnp.pad(t[:, :, :, :-1], ((0, 0), (0, 0), (0, 0), (1, 0), (0, 0), (0, 0)))
        return jnp.concatenate([prev, t], axis=4)

    qb = fold(q)
    kw = with_prev(fold(k))
    vw = with_prev(fold(v))
    s = jnp.einsum('bhrnqd,bhrnkd->bhrnqk', qb, kw).astype(jnp.float32) * (hd ** -0.5)
    qi = jnp.arange(BLOCK)[:, None]
    ki = jnp.arange(2 * BLOCK)[None, :]
    delta = BLOCK + qi - ki
    kidx = jnp.arange(nb)[:, None, None] * BLOCK - BLOCK + ki
    valid = (delta >= 0) & (delta <= steps) & (kidx >= 0)
    s = jnp.where(valid, s, -jnp.inf)
    m = jnp.max(s, axis=-1)
    p = jnp.exp(s - m[..., None])
    l = jnp.sum(p, axis=-1)
    o = jnp.einsum('bhrnqk,bhrnkd->bhrnqd', p.astype(v.dtype), vw).astype(jnp.float32) / l[..., None]

    def unfold(t):
        t = t.reshape((B, H, dil, Lp) + t.shape[5:])[:, :, :, :L]
        t = jnp.swapaxes(t, 2, 3)
        return t.reshape((B, H, S) + t.shape[4:])

    return unfold(o), unfold(m), unfold(l)


def dilated_attention(q, k, v):
    res = [dilated_branch(q, k, v, w, r) for (w, r) in DILATED_PATTERNS]
    o_all = jnp.stack([r_[0] for r_ in res])
    m_all = jnp.stack([r_[1] for r_ in res])
    l_all = jnp.stack([r_[2] for r_ in res])
    wts = l_all * jnp.exp(m_all - jnp.max(m_all, axis=0, keepdims=True))
    wts = wts / jnp.sum(wts, axis=0, keepdims=True)
    return jnp.sum(o_all * wts[..., None], axis=0).astype(q.dtype)


def forgetting_attention(q, k, v, logf):
    B, H, S, hd = q.shape
    nb = S // BLOCK
    c = jnp.cumsum(logf.astype(jnp.float32), axis=-1)
    qb = q.reshape(B, H, nb, BLOCK, hd).transpose(2, 0, 1, 3, 4)
    cq = c.reshape(B, H, nb, BLOCK).transpose(2, 0, 1, 3)
    kpos = jnp.arange(S)

    def block(args):
        q_i, c_i, i = args
        s = jnp.einsum('bhqd,bhkd->bhqk', q_i, k).astype(jnp.float32) * (hd ** -0.5)
        s = s + c_i[..., :, None] - c[:, :, None, :]
        qpos = i * BLOCK + jnp.arange(BLOCK)
        s = jnp.where(kpos[None, :] <= qpos[:, None], s, -jnp.inf)
        p = jax.nn.softmax(s, axis=-1)
        return jnp.einsum('bhqk,bhkd->bhqd', p.astype(v.dtype), v)

    o = lax.map(block, (qb, cq, jnp.arange(nb)))
    return o.transpose(1, 2, 0, 3, 4).reshape(B, H, S, hd)


def hybrid_mixer(h, w_in, b_forget, g_dil, g_fox, w_out):
    B, S, _ = h.shape
    z = h @ w_in
    cuts = np.cumsum([D_DIL, D_DIL, D_DIL, D_FOX, D_FOX, D_FOX]).tolist()
    qa, ka, va, qf, kf, vf, zf = jnp.split(z, cuts, axis=-1)

    def heads(t, n):
        return t.reshape(B, S, n, HEAD_DIM).transpose(0, 2, 1, 3)

    def merge(t):
        return t.transpose(0, 2, 1, 3).reshape(B, S, -1)

    pos = jnp.arange(S, dtype=jnp.float32)
    o_dil = dilated_attention(rope(heads(qa, N_HEADS_DIL), pos),
                              rope(heads(ka, N_HEADS_DIL), pos),
                              heads(va, N_HEADS_DIL))
    logf = jax.nn.log_sigmoid((zf + b_forget).astype(jnp.float32)).transpose(0, 2, 1)
    o_fox = forgetting_attention(heads(qf, N_HEADS_FOX), heads(kf, N_HEADS_FOX),
                                 heads(vf, N_HEADS_FOX), logf)
    y = jnp.concatenate([rms_norm(merge(o_dil), g_dil), rms_norm(merge(o_fox), g_fox)], axis=-1)
    return y @ w_out


def grouped_moe(h, w_router, b_router, w_gate, w_up, w_down):
    B, S, D = h.shape
    xt = h.reshape(-1, D)
    T = xt.shape[0]
    logits = (xt @ w_router).astype(jnp.float32) + b_router.astype(jnp.float32)
    probs = jax.nn.softmax(logits, axis=-1)
    grp = probs.reshape(T, N_GROUPS, EXPERTS_PER_GROUP)
    gscore = jnp.sum(lax.top_k(grp, TOP_K)[0], axis=-1)
    gsel = jnp.argmax(gscore, axis=-1)
    in_grp = jnp.take_along_axis(grp, gsel[:, None, None], axis=1)[:, 0]
    gv, gi = lax.top_k(in_grp, TOP_K)
    experts = gsel[:, None] * EXPERTS_PER_GROUP + gi
    gates = gv / jnp.sum(gv, axis=-1, keepdims=True)

    TK = T * TOP_K
    flat_e = experts.reshape(-1).astype(jnp.int32)
    flat_t = jnp.repeat(jnp.arange(T, dtype=jnp.int32), TOP_K)
    flat_g = gates.reshape(-1)
    order = jnp.argsort(flat_e, stable=True)
    se = flat_e[order]
    counts = jnp.bincount(flat_e, length=N_EXPERTS)
    pcounts = (counts + BLOCK - 1) // BLOCK * BLOCK
    pends = jnp.cumsum(pcounts)
    pstarts = pends - pcounts
    starts = jnp.cumsum(counts) - counts
    dest = pstarts[se] + (jnp.arange(TK) - starts[se])
    NB = -(-TK // BLOCK) + N_EXPERTS
    rows = NB * BLOCK
    row_tok = jnp.full((rows,), T, jnp.int32).at[dest].set(flat_t[order])
    row_gate = jnp.zeros((rows,), jnp.float32).at[dest].set(flat_g[order])
    blk_e = jnp.minimum(jnp.searchsorted(pends, jnp.arange(NB) * BLOCK, side='right'), N_EXPERTS - 1)
    xpad = jnp.concatenate([xt, jnp.zeros((1, D), xt.dtype)], axis=0)
    xb = xpad[row_tok].reshape(NB, BLOCK, D)

    def expert_block(args):
        xblk, e = args
        a = jax.nn.silu(xblk @ w_gate[e]) * (xblk @ w_up[e])
        return a @ w_down[e]

    yb = lax.map(expert_block, (xb, blk_e)).reshape(rows, D).astype(jnp.float32)
    out = jnp.zeros((T + 1, D), jnp.float32).at[row_tok].add(yb * row_gate[:, None])[:T]
    return out.reshape(B, S, D).astype(h.dtype)


def setup_inputs(seed: int = 0) -> dict:
    key = jax.random.key(seed)
    ks = jax.random.split(key, 16)
    f32 = jnp.float32

    def nrm(k, shape, scale):
        return jax.random.normal(k, shape, f32) * scale

    x = jax.random.normal(ks[0], (BATCH, SEQ, D_MODEL), f32)
    col_scale = jnp.concatenate([
        jnp.ones((2 * D_DIL,), f32), jnp.full((D_DIL,), DEEPNORM_BETA, f32),
        jnp.ones((2 * D_FOX,), f32), jnp.full((D_FOX,), DEEPNORM_BETA, f32),
        jnp.ones((N_HEADS_FOX,), f32)])
    w_in = nrm(ks[1], (DEPTH, D_MODEL, D_PROJ), D_MODEL ** -0.5) * col_scale
    b_forget = 3.0 + nrm(ks[2], (DEPTH, N_HEADS_FOX), 0.5)
    g_dil = 1.0 + nrm(ks[3], (DEPTH, D_DIL), 0.02)
    g_fox = 1.0 + nrm(ks[4], (DEPTH, D_FOX), 0.02)
    w_out = nrm(ks[5], (DEPTH, D_MIX, D_MODEL), D_MIX ** -0.5 * DEEPNORM_BETA)
    ln1_g = 1.0 + nrm(ks[6], (DEPTH, D_MODEL), 0.02)
    ln1_b = nrm(ks[7], (DEPTH, D_MODEL), 0.02)
    w_router = nrm(ks[8], (D_MODEL, N_EXPERTS), D_MODEL ** -0.5)
    b_router = nrm(ks[9], (N_EXPERTS,), 0.01)
    w_gate = nrm(ks[10], (DEPTH, N_EXPERTS, D_MODEL, D_FF_EXPERT), D_MODEL ** -0.5)
    w_up = nrm(ks[11], (DEPTH, N_EXPERTS, D_MODEL, D_FF_EXPERT), D_MODEL ** -0.5)
    w_down = nrm(ks[12], (DEPTH, N_EXPERTS, D_FF_EXPERT, D_MODEL), D_FF_EXPERT ** -0.5 * DEEPNORM_BETA)
    ln2_g = 1.0 + nrm(ks[13], (DEPTH, D_MODEL), 0.02)
    ln2_b = nrm(ks[14], (DEPTH, D_MODEL), 0.02)
    return {'x': x, 'w_in': w_in, 'b_forget': b_forget, 'g_dil': g_dil, 'g_fox': g_fox,
            'w_out': w_out, 'ln1_g': ln1_g, 'ln1_b': ln1_b, 'w_router': w_router,
            'b_router': b_router, 'w_gate': w_gate, 'w_up': w_up, 'w_down': w_down,
            'ln2_g': ln2_g, 'ln2_b': ln2_b}


def reference(x, w_in, b_forget, g_dil, g_fox, w_out, ln1_g, ln1_b, w_router,
              b_router, w_gate, w_up, w_down, ln2_g, ln2_b):
    h = x
    for l in range(DEPTH):
        y = hybrid_mixer(h, w_in[l], b_forget[l], g_dil[l], g_fox[l], w_out[l])
        h = layer_norm(DEEPNORM_ALPHA * h + y, ln1_g[l], ln1_b[l])
        y = grouped_moe(h, w_router, b_router, w_gate[l], w_up[l], w_down[l])
        h = layer_norm(DEEPNORM_ALPHA * h + y, ln2_g[l], ln2_b[l])
    return h
```

```cpp
#include <hip/hip_runtime.h>
#include <stdint.h>
#include <math.h>
#include <cstdio>

#ifndef MK_DEBUG
#define MK_DEBUG 0
#endif
#ifndef NAIVE_MASK
#define NAIVE_MASK 0
#endif

typedef unsigned short bf16;
constexpr int NB = 8, S = 4096, D = 1024, T = NB * S, DEPTH = 2;
constexpr int NPROJ = 3076, NZ = 3072;
constexpr int HD_DIL = 12, HD_FOX = 4;
constexpr int NE = 16;
constexpr int RB = 256;
constexpr int ROWS_MAX = 2 * T + NE * RB;
constexpr int NBLK_MAX = ROWS_MAX / RB;
constexpr float ALPHA = 1.41421356237f;
constexpr float LN_EPS = 1e-5f, RMS_EPS = 1e-6f;
constexpr float LOG2E = 1.4426950408889634f;
constexpr float C2 = 0.125f * LOG2E;
constexpr size_t RQA = 0, RKA = (size_t)T * 768, RVA = (size_t)T * 1536, RQF = (size_t)T * 2304, RKF = (size_t)T * 2560, RVF = (size_t)T * 2816;

__device__ __forceinline__ float bf2f(bf16 v) { return __uint_as_float(((unsigned)v) << 16); }
__device__ __forceinline__ bf16 f2bf(float f) { unsigned u = __float_as_uint(f); return (bf16)((u + 0x7fffu + ((u >> 16) & 1u)) >> 16); }
typedef float f32x2_cv __attribute__((ext_vector_type(2))); typedef __bf16 bf16x2_cv __attribute__((ext_vector_type(2)));
__device__ __forceinline__ unsigned pk2(float lo, float hi) { f32x2_cv v = {lo, hi}; bf16x2_cv b = __builtin_convertvector(v, bf16x2_cv); return __builtin_bit_cast(unsigned, b); }

constexpr size_t MiB = 1u << 20;
constexpr size_t WS_Z = 0;
constexpr size_t WS_OP = 192 * MiB;
constexpr size_t WS_H0 = 336 * MiB;
constexpr size_t WS_H1 = 401 * MiB;
constexpr size_t WS_WIO = 466 * MiB;
constexpr size_t WS_SM = 482 * MiB;
constexpr size_t SM_CTL = 0;
constexpr size_t SM_LOGF = 1 * MiB;
constexpr size_t SM_CUM = 2 * MiB;
constexpr size_t SM_TOKE = 3 * MiB;
constexpr size_t SM_TOKG = 4 * MiB;
constexpr size_t SM_SLOT = 5 * MiB;
constexpr size_t SM_ROWTOK = 6 * MiB;
constexpr size_t SM_RT = 7 * MiB;
constexpr size_t SM_WF = 8 * MiB;
constexpr size_t SM_ML = 9 * MiB;
constexpr size_t SM_OF = 18 * MiB;
constexpr size_t WS_END = WS_SM + 34 * MiB;
constexpr size_t OUT_WG = 0, OUT_WU = 32 * MiB, OUT_WD = 64 * MiB;
constexpr size_t OUT_WG8 = 0, OUT_WU8 = 16 * MiB, OUT_WD8 = 32 * MiB, OUT_WL = 48 * MiB;
constexpr size_t WS_H1Q = WS_Z + 128 * MiB;
#ifndef MOE_FP8_L0
#define MOE_FP8_L0 1
#endif
#ifndef MOE_FP8_L1
#define MOE_FP8_L1 1
#endif
constexpr int CW_BAR = 4096;
constexpr int CW_CQ = 20480;
constexpr int CW_DQ = 16384;
constexpr int CW_KMAXD = 8320;
constexpr int CW_KMAX = 8192;

namespace pg8 {
#define PG8_LAS __attribute__((address_space(3)))
typedef unsigned short bf16_t;
typedef short bf16x8 __attribute__((ext_vector_type(8)));
typedef float f32x4 __attribute__((ext_vector_type(4)));
typedef unsigned u32x4 __attribute__((ext_vector_type(4)));
constexpr int BM = 256, BK = 64, HALF = 128, HTB = HALF * BK * 2, STAGE_BYTES = 8 * HTB, NXCD = 8, WGM = 8;
constexpr int GT_MAX = 10;
constexpr int GTAB_OFF = STAGE_BYTES;
constexpr int ETAB_OFF = GTAB_OFF + GT_MAX * 1024;

__host__ __device__ __forceinline__ int lds_byte(int r, int c) { const int st = (r >> 4) * 2 + (c >> 5), rr = r & 15, cc = c & 31, ob = rr * 64 + cc * 2; return st * 1024 + (ob ^ (((ob >> 9) & 1) << 5)); }
__host__ __device__ __forceinline__ void stage_rc(int b, int& R, int& C) { const int st = b / 1024, sb = b % 1024, swz = sb ^ (((sb >> 9) & 1) << 5); R = (st >> 1) * 16 + swz / 64; C = (st & 1) * 32 + (swz % 64) / 2; }
__host__ __device__ __forceinline__ int perm32(int rho) { const int n = rho >> 4, i = rho & 15; return 8 * (i >> 2) + 4 * n + (i & 3); }

struct Unit { int pm, pn; };
struct TileOrder {
    int nM, nN, nwg, G, c;
    __device__ void init(int nM_, int nN_, int G_, int c_) { nM = nM_; nN = nN_; nwg = nM * nN; G = G_; c = c_; }
    __device__ bool next(int i, Unit& u) const {
        const long L = (long)i * G + c; if (L >= nwg) return false;
        int wgid = (int)L; { const int q = nwg / NXCD, r = nwg % NXCD, xcd = wgid % NXCD, off = wgid / NXCD; wgid = (xcd < r ? xcd * (q + 1) : r * (q + 1) + (xcd - r) * q) + off; }
        const int nig = WGM * nN, gid = wgid / nig, fm = gid * WGM, gsz = (nM - fm) < WGM ? (nM - fm) : WGM;
        u.pm = fm + ((wgid % nig) % gsz); u.pn = (wgid % nig) / gsz; return true;
    }
};
struct Gemm { const void* A; const void* B0; const int* gather; const int* blk_e; };

__device__ __forceinline__ unsigned cvt_pk_bf16(float lo, float hi) { unsigned r; asm volatile("v_cvt_pk_bf16_f32 %0, %1, %2" : "=v"(r) : "v"(lo), "v"(hi)); return r; }

#ifndef WT_STORES
#define WT_STORES 0
#endif
__device__ __forceinline__ void st16(void* p, u32x4 v) {
#if WT_STORES
    asm volatile("global_store_dwordx4 %0, %1, off sc1\n\ts_nop 1" :: "v"(p), "v"(v) : "memory");
#else
    *(u32x4*)p = v;
#endif
}
typedef unsigned u32x2_st __attribute__((ext_vector_type(2)));
__device__ __forceinline__ void st8(void* p, u32x2_st v) {
#if WT_STORES
    asm volatile("global_store_dwordx2 %0, %1, off sc1\n\ts_nop 1" :: "v"(p), "v"(v) : "memory");
#else
    *(u32x2_st*)p = v;
#endif
}
struct EpiPlain {
    bf16_t* O; int ldc; float sc;
    __device__ __forceinline__ void operator()(const f32x4 (&acc)[2][2][4][2], const Unit& u, int wr, int wc, int fr, int fq) const {
        const int row0 = u.pm * BM + wr * 64 + fr; const int col0 = u.pn * BM + wc * 32 + 8 * fq;
#pragma unroll
        for (int ai = 0; ai < 2; ++ai)
#pragma unroll
            for (int m = 0; m < 4; ++m) { bf16_t* rowp = O + (size_t)(row0 + ai * HALF + m * 16) * ldc + col0;
#pragma unroll
                for (int bj = 0; bj < 2; ++bj) { const f32x4 v0 = acc[ai][bj][m][0], v1 = acc[ai][bj][m][1];
                    u32x4 w; w.x = cvt_pk_bf16(v0[0], v0[1]); w.y = cvt_pk_bf16(v0[2], v0[3]); w.z = cvt_pk_bf16(v1[0], v1[1]); w.w = cvt_pk_bf16(v1[2], v1[3]);
                    st16(rowp + bj * HALF, w); } }
    }
};
struct EpiPlain8 {
    unsigned char* O; float sc;
    __device__ __forceinline__ void operator()(const f32x4 (&acc)[2][2][4][2], const Unit& u, int wr, int wc, int fr, int fq) const {
        const int row0 = u.pm * BM + wr * 64 + fr; const int col0 = u.pn * BM + wc * 32 + 8 * fq;
#pragma unroll
        for (int ai = 0; ai < 2; ++ai)
#pragma unroll
            for (int m = 0; m < 4; ++m) { unsigned char* rowp = O + (size_t)(row0 + ai * HALF + m * 16) * 1024 + col0;
#pragma unroll
                for (int bj = 0; bj < 2; ++bj) { const f32x4 v0 = acc[ai][bj][m][0] * sc, v1 = acc[ai][bj][m][1] * sc;
                    int w0 = 0, w1 = 0;
                    w0 = __builtin_amdgcn_cvt_pk_fp8_f32(v0[0], v0[1], w0, false); w0 = __builtin_amdgcn_cvt_pk_fp8_f32(v0[2], v0[3], w0, true);
                    w1 = __builtin_amdgcn_cvt_pk_fp8_f32(v1[0], v1[1], w1, false); w1 = __builtin_amdgcn_cvt_pk_fp8_f32(v1[2], v1[3], w1, true);
                    st8(rowp + bj * HALF, (u32x2_st){(unsigned)w0, (unsigned)w1}); } }
    }
};
struct EpiSwiglu {
    bf16_t* O;
    __device__ __forceinline__ void operator()(const f32x4 (&acc)[2][2][4][2], const Unit& u, int wr, int wc, int fr, int fq) const {
        const int row0 = u.pm * BM + wr * 64 + fr; const int col0 = u.pn * HALF + wc * 32 + 8 * fq;
#pragma unroll
        for (int ai = 0; ai < 2; ++ai)
#pragma unroll
            for (int m = 0; m < 4; ++m) { bf16_t* rowp = O + (size_t)(row0 + ai * HALF + m * 16) * 1024 + col0;
                float r[8];
#pragma unroll
                for (int n = 0; n < 2; ++n)
#pragma unroll
                    for (int j = 0; j < 4; ++j) { const float g = acc[ai][0][m][n][j], up = acc[ai][1][m][n][j];
                        r[n * 4 + j] = g * __builtin_amdgcn_rcpf(1.f + __builtin_amdgcn_exp2f(-g * LOG2E)) * up; }
                u32x4 w; w.x = cvt_pk_bf16(r[0], r[1]); w.y = cvt_pk_bf16(r[2], r[3]); w.z = cvt_pk_bf16(r[4], r[5]); w.w = cvt_pk_bf16(r[6], r[7]);
                st16(rowp, w); __builtin_amdgcn_sched_barrier(0); }
    }
};
struct EpiSwiglu8 {
    unsigned char* O;
    __device__ __forceinline__ void operator()(const f32x4 (&acc)[2][2][4][2], const Unit& u, int wr, int wc, int fr, int fq) const {
        typedef unsigned u32x2 __attribute__((ext_vector_type(2)));
        const int row0 = u.pm * BM + wr * 64 + fr; const int col0 = u.pn * HALF + wc * 32 + 8 * fq;
#pragma unroll
        for (int ai = 0; ai < 2; ++ai)
#pragma unroll
            for (int m = 0; m < 4; ++m) { unsigned char* rowp = O + (size_t)(row0 + ai * HALF + m * 16) * 1024 + col0;
                float r[8];
#pragma unroll
                for (int n = 0; n < 2; ++n)
#pragma unroll
                    for (int jp = 0; jp < 2; ++jp) { typedef float f32x2_ __attribute__((ext_vector_type(2)));
                        const f32x2_ g2 = {acc[ai][0][m][n][2 * jp], acc[ai][0][m][n][2 * jp + 1]}, u2 = {acc[ai][1][m][n][2 * jp], acc[ai][1][m][n][2 * jp + 1]};
                        const f32x2_ x2 = g2 * (-LOG2E / 32.f);
                        const f32x2_ e2 = {__builtin_amdgcn_exp2f(x2.x), __builtin_amdgcn_exp2f(x2.y)};
                        const f32x2_ d2 = e2 * 1024.f + 1024.f;
                        const f32x2_ q2 = {__builtin_amdgcn_rcpf(d2.x), __builtin_amdgcn_rcpf(d2.y)};
                        const f32x2_ o2 = (g2 * u2) * q2;
                        r[n * 4 + 2 * jp] = o2.x; r[n * 4 + 2 * jp + 1] = o2.y; }
                int w0 = 0, w1 = 0;
                w0 = __builtin_amdgcn_cvt_pk_fp8_f32(r[0], r[1], w0, false); w0 = __builtin_amdgcn_cvt_pk_fp8_f32(r[2], r[3], w0, true);
                w1 = __builtin_amdgcn_cvt_pk_fp8_f32(r[4], r[5], w1, false); w1 = __builtin_amdgcn_cvt_pk_fp8_f32(r[6], r[7], w1, true);
                st8(rowp, (u32x2_st){(unsigned)w0, (unsigned)w1}); __builtin_amdgcn_sched_barrier(0); }
    }
};
struct EpiInproj {
    bf16_t* Z; unsigned* kmax; unsigned* kmaxd;
    __device__ __forceinline__ void operator()(const f32x4 (&acc)[2][2][4][2], const Unit& u, int wr, int wc, int fr, int fq) const {
        const int row0 = u.pm * BM + wr * 64 + fr;
        const int bb = (u.pm * BM) / S;
        if (u.pn < 6) {
            typedef float f32x2_ __attribute__((ext_vector_type(2)));
            f32x2_ ir2[4], cd2[4], sd2[4];
#pragma unroll
            for (int p = 0; p < 4; ++p) {
                ir2[p] = (f32x2_){__builtin_amdgcn_exp2f(-(float)(8 * fq + 2 * p) * (13.287712379549449f / 32.f)) * 0.15915494309189535f, __builtin_amdgcn_exp2f(-(float)(8 * fq + 2 * p + 1) * (13.287712379549449f / 32.f)) * 0.15915494309189535f};
                const f32x2_ r16 = ir2[p] * 16.f;
                cd2[p] = (f32x2_){__builtin_amdgcn_cosf(__builtin_amdgcn_fractf(r16.x)), __builtin_amdgcn_cosf(__builtin_amdgcn_fractf(r16.y))};
                sd2[p] = (f32x2_){__builtin_amdgcn_sinf(__builtin_amdgcn_fractf(r16.x)), __builtin_amdgcn_sinf(__builtin_amdgcn_fractf(r16.y))}; }
            const int head = 4 * (u.pn % 3) + wc;
            bf16_t* base = Z + (u.pn < 3 ? RQA : RKA) + ((size_t)(bb * HD_DIL + head) * S) * 64 + 8 * fq;
            float knrm = 0.f;
#pragma unroll
            for (int ai = 0; ai < 2; ++ai) {
                f32x2_ c2[4], s2[4];
                { const float pos0 = (float)((row0 + ai * HALF) & (S - 1));
#pragma unroll
                  for (int p = 0; p < 4; ++p) { const f32x2_ rv = ir2[p] * pos0; const float r0 = __builtin_amdgcn_fractf(rv.x), r1 = __builtin_amdgcn_fractf(rv.y);
                      c2[p] = (f32x2_){__builtin_amdgcn_cosf(r0), __builtin_amdgcn_cosf(r1)}; s2[p] = (f32x2_){__builtin_amdgcn_sinf(r0), __builtin_amdgcn_sinf(r1)}; } }
#pragma unroll
                for (int m = 0; m < 4; ++m) { const int row = row0 + ai * HALF + m * 16; const int spos = row & (S - 1);
                    if (m > 0) {
#pragma unroll
                        for (int p = 0; p < 4; ++p) { const f32x2_ cn = c2[p] * cd2[p] - s2[p] * sd2[p]; s2[p] = s2[p] * cd2[p] + c2[p] * sd2[p]; c2[p] = cn; } }
                    float o1[8], o2[8];
#pragma unroll
                    for (int p = 0; p < 4; ++p) { const int n = p >> 1, j = 2 * (p & 1);
                        const f32x2_ t1 = {acc[ai][0][m][n][j], acc[ai][0][m][n][j + 1]}, t2 = {acc[ai][1][m][n][j], acc[ai][1][m][n][j + 1]};
                        const f32x2_ a1 = t1 * c2[p] - t2 * s2[p], a2 = t2 * c2[p] + t1 * s2[p];
                        o1[2 * p] = a1.x; o1[2 * p + 1] = a1.y; o2[2 * p] = a2.x; o2[2 * p + 1] = a2.y; }
                    bf16_t* rowp = base + (size_t)spos * 64;
                    u32x4 w; w.x = cvt_pk_bf16(o1[0], o1[1]); w.y = cvt_pk_bf16(o1[2], o1[3]); w.z = cvt_pk_bf16(o1[4], o1[5]); w.w = cvt_pk_bf16(o1[6], o1[7]);
                    st16(rowp, w);
                    w.x = cvt_pk_bf16(o2[0], o2[1]); w.y = cvt_pk_bf16(o2[2], o2[3]); w.z = cvt_pk_bf16(o2[4], o2[5]); w.w = cvt_pk_bf16(o2[6], o2[7]);
                    st16(rowp + 32, w);
                    if (u.pn >= 3) { float p = 0.f;
#pragma unroll
                        for (int k = 0; k < 8; ++k) p += o1[k] * o1[k] + o2[k] * o2[k];
                        p += __shfl_xor(p, 16); p += __shfl_xor(p, 32); knrm = fmaxf(knrm, p); }
                    __builtin_amdgcn_sched_barrier(0); } }
            if (u.pn >= 3) { knrm = fmaxf(knrm, __shfl_xor(knrm, 1)); knrm = fmaxf(knrm, __shfl_xor(knrm, 2)); knrm = fmaxf(knrm, __shfl_xor(knrm, 4)); knrm = fmaxf(knrm, __shfl_xor(knrm, 8));
                if (fr == 0 && fq == 0) atomicMax(kmaxd + bb * HD_DIL + head, __float_as_uint(knrm)); }
        } else {
            const bool fox = u.pn >= 9; const int nh = fox ? HD_FOX : HD_DIL;
            const size_t reg = u.pn < 9 ? RVA : (u.pn == 9 ? RQF : (u.pn == 10 ? RKF : RVF));
            const int head0 = (fox ? 0 : 4 * (u.pn - 6)) + (wc >> 1);
            bf16_t* base = Z + reg + 32 * (wc & 1) + 8 * fq;
#pragma unroll
            for (int ai = 0; ai < 2; ++ai)
#pragma unroll
                for (int m = 0; m < 4; ++m) { const int spos = (row0 + ai * HALF + m * 16) & (S - 1);
#pragma unroll
                    for (int bj = 0; bj < 2; ++bj) { const f32x4 v0 = acc[ai][bj][m][0], v1 = acc[ai][bj][m][1];
                        u32x4 w; w.x = cvt_pk_bf16(v0[0], v0[1]); w.y = cvt_pk_bf16(v0[2], v0[3]); w.z = cvt_pk_bf16(v1[0], v1[1]); w.w = cvt_pk_bf16(v1[2], v1[3]);
                        st16(base + ((size_t)(bb * nh + head0 + 2 * bj) * S + spos) * 64, w); } }
#ifndef FOX_NOKMAX
            if (u.pn == 10) {
#pragma unroll
                for (int bj = 0; bj < 2; ++bj) { float mxp = 0.f;
#pragma unroll
                    for (int ai = 0; ai < 2; ++ai)
#pragma unroll
                        for (int m = 0; m < 4; ++m) { const f32x4 a0 = acc[ai][bj][m][0], a1 = acc[ai][bj][m][1];
                            float p = (a0[0] * a0[0] + a0[1] * a0[1]) + (a0[2] * a0[2] + a0[3] * a0[3]) + (a1[0] * a1[0] + a1[1] * a1[1]) + (a1[2] * a1[2] + a1[3] * a1[3]);
                            p += __shfl_xor(p, 16); p += __shfl_xor(p, 32); mxp = fmaxf(mxp, p); }
                    mxp = fmaxf(mxp, __shfl_xor(mxp, 1)); mxp = fmaxf(mxp, __shfl_xor(mxp, 2)); mxp = fmaxf(mxp, __shfl_xor(mxp, 4)); mxp = fmaxf(mxp, __shfl_xor(mxp, 8));
                    if (fr == 0 && fq == 0) atomicMax(kmax + ((bb * HD_FOX + head0 + 2 * bj) * 2 + (wc & 1)), __float_as_uint(mxp)); }
            }
#endif
        }
    }
};

template <class Epi, long BHSTEP  , int BN_ROWS, bool GATHER, bool GROUPED, bool FP8 = false, bool ALIGN = true>
__device__ __forceinline__ void gemm_phase(PG8_LAS unsigned char* lds, const Gemm g, const TileOrder& S, const Epi& E, const int tid) {
    const int wid = __builtin_amdgcn_readfirstlane(tid >> 6), lane = tid & 63, wr = wid >> 2, wc = wid & 3, fr = lane & 15, fq = lane >> 4;
    constexpr int K = 1024, KB = FP8 ? K : 2 * K  , nt = KB / (BK * 2)  ; constexpr long ESTRIDE = (long)K * KB;
    PG8_LAS int* gtab = (PG8_LAS int*)(lds + GTAB_OFF); PG8_LAS int* etab = (PG8_LAS int*)(lds + ETAB_OFF);
    unsigned voffB[2];
#pragma unroll
    for (int i = 0; i < 2; ++i) { int R, C; stage_rc(tid * 16 + i * 8192, R, C); const int Rb = (R & ~31) + perm32(R & 31); voffB[i] = (unsigned)(Rb * KB + C * 2); }
    if (GATHER || GROUPED) {
        Unit u; int i = 0;
        for (; i < GT_MAX && S.next(i, u); ++i) {
            if (GATHER && tid < 256) gtab[i * 256 + tid] = g.gather[u.pm * BM + tid];
            if (GROUPED && tid == 0) etab[i] = g.blk_e[u.pm];
        }
        __syncthreads();
    }
    const unsigned ldsw = (unsigned)wid * 1024u;
    const int aoff = lds_byte(wr * 64 + fr, fq * 8), boff = lds_byte(wc * 32 + fr, fq * 8);
#define PG8_SA(b, h) (((b) * 2 + (h)) * HTB)
#define PG8_SB(b, h) ((4 + (b) * 2 + (h)) * HTB)
#define PG8_STAGE(bufoff, gbase, voff) do { _Pragma("unroll") for (int _i = 0; _i < 2; ++_i) \
        __builtin_amdgcn_global_load_lds((const unsigned*)((const char*)(gbase) + (voff)[_i]), (PG8_LAS unsigned*)(lds + (bufoff) + ldsw + _i * 8192), 16, 0, 0); } while (0)
#define PG8_LDA(dst, b, h) do { _Pragma("unroll") for (int m = 0; m < 4; ++m) _Pragma("unroll") for (int k = 0; k < 2; ++k) dst[m][k] = *(const PG8_LAS bf16x8*)(lds + PG8_SA(b, h) + aoff + m * 2048 + k * 1024); } while (0)
#define PG8_LDB(dst, b, h) do { _Pragma("unroll") for (int n = 0; n < 2; ++n) _Pragma("unroll") for (int k = 0; k < 2; ++k) dst[n][k] = *(const PG8_LAS bf16x8*)(lds + PG8_SB(b, h) + boff + n * 2048 + k * 1024); } while (0)
#define PG8_MMA(ai, bj, At, Bt) do { __builtin_amdgcn_s_setprio(1); \
        if constexpr (FP8) { _Pragma("unroll") for (int m = 0; m < 4; ++m) _Pragma("unroll") for (int n = 0; n < 2; ++n) { \
            typedef int v4i_ __attribute__((ext_vector_type(4))); typedef int v8i_ __attribute__((ext_vector_type(8))); \
            const v8i_ a8 = __builtin_shufflevector(__builtin_bit_cast(v4i_, At[m][0]), __builtin_bit_cast(v4i_, At[m][1]), 0, 1, 2, 3, 4, 5, 6, 7); \
            const v8i_ b8 = __builtin_shufflevector(__builtin_bit_cast(v4i_, Bt[n][0]), __builtin_bit_cast(v4i_, Bt[n][1]), 0, 1, 2, 3, 4, 5, 6, 7); \
            acc[ai][bj][m][n] = __builtin_amdgcn_mfma_scale_f32_16x16x128_f8f6f4(b8, a8, acc[ai][bj][m][n], 0, 0, 0, 0x7f7f7f7f, 0, 0x7f7f7f7f); } } \
        else { _Pragma("unroll") for (int m = 0; m < 4; ++m) _Pragma("unroll") for (int n = 0; n < 2; ++n) _Pragma("unroll") for (int k = 0; k < 2; ++k) \
            acc[ai][bj][m][n] = __builtin_amdgcn_mfma_f32_16x16x32_bf16(Bt[n][k], At[m][k], acc[ai][bj][m][n], 0, 0, 0); } \
        __builtin_amdgcn_s_setprio(0); } while (0)
#define PG8_WAIT_V(n) asm volatile("s_waitcnt vmcnt(" #n ")" ::: "memory")
#define PG8_WAIT_L(n) asm volatile("s_waitcnt lgkmcnt(" #n ")" ::: "memory")
#define PG8_BAR __builtin_amdgcn_s_barrier()
#define PG8_SCHED __builtin_amdgcn_sched_barrier(0)
#define PG8_UNIT_ADDR(u, ui_, ao, b0) do { \
        _Pragma("unroll") for (int h = 0; h < 2; ++h) _Pragma("unroll") for (int i = 0; i < 2; ++i) { int R_, C_; stage_rc(tid * 16 + i * 8192, R_, C_); \
            int row_ = (u).pm * BM + h * HALF + R_; if (GATHER) row_ = gtab[(ui_) * 256 + h * HALF + R_]; \
            ao[h][i] = (unsigned)(row_ * KB + C_ * 2); } \
        const int e_ = GROUPED ? __builtin_amdgcn_readfirstlane(etab[(ui_)]) : 0; \
        b0 = (const char*)g.B0 + (size_t)e_ * ESTRIDE + (size_t)(u).pn * BN_ROWS * KB; } while (0)
    Unit cur, nxt; int ui = 0;
    if (!S.next(0, cur)) return;
    f32x4 acc[2][2][4][2];
#pragma unroll
    for (int a = 0; a < 2; ++a)
#pragma unroll
        for (int b = 0; b < 2; ++b)
#pragma unroll
            for (int m = 0; m < 4; ++m)
#pragma unroll
                for (int n = 0; n < 2; ++n) acc[a][b][m][n] = (f32x4){0.f, 0.f, 0.f, 0.f};
    bf16x8 At[4][2], B0[2][2], B1[2][2];
    unsigned aC[2][2]; const char *cB0, *nB0; constexpr size_t bh = (size_t)BHSTEP;
    const char* gA = (const char*)g.A;
    PG8_UNIT_ADDR(cur, 0, aC, cB0);
    const size_t kstep = (size_t)(BK * 2);
    PG8_STAGE(PG8_SB(0, 0), cB0, voffB); PG8_STAGE(PG8_SB(0, 1), cB0 + bh, voffB); PG8_STAGE(PG8_SA(0, 0), gA, aC[0]); PG8_STAGE(PG8_SA(0, 1), gA, aC[1]);
    if (wr == 1) PG8_BAR;
    PG8_WAIT_V(2); PG8_BAR;
    PG8_STAGE(PG8_SB(1, 0), cB0 + kstep, voffB); PG8_STAGE(PG8_SA(1, 0), gA + kstep, aC[0]); PG8_STAGE(PG8_SB(1, 1), cB0 + bh + kstep, voffB);
    PG8_WAIT_V(6); PG8_BAR;
    for (;;) {
        const bool has_next = S.next(ui + 1, nxt);
        nB0 = cB0;
        for (int t = 0; t < nt; t += 2) {
            const bool last = (t == nt - 2);
            const char* a1 = gA + (size_t)(t + 1) * kstep;
            const char* a2 = last ? gA : gA + (size_t)(t + 2) * kstep; const char* a3 = a2 + kstep;
            PG8_LDB(B0, 0, 0); PG8_LDB(B1, 0, 1); PG8_SCHED; PG8_LDA(At, 0, 0); PG8_STAGE(PG8_SA(1, 1), a1, aC[1]);
            PG8_WAIT_V(8); PG8_WAIT_L(0); PG8_BAR; PG8_MMA(0, 0, At, B0); PG8_MMA(0, 1, At, B1); PG8_BAR; PG8_SCHED;
            if (last && has_next) { PG8_UNIT_ADDR(nxt, ui + 1, aC, nB0); }
            const char* b20 = last ? nB0 : cB0 + (size_t)(t + 2) * kstep; const char* b30 = b20 + kstep;
            PG8_LDA(At, 0, 1); PG8_STAGE(PG8_SB(0, 0), b20, voffB); PG8_STAGE(PG8_SB(0, 1), b20 + bh, voffB); PG8_STAGE(PG8_SA(0, 0), a2, aC[0]);
            PG8_WAIT_V(8); PG8_WAIT_L(0); PG8_BAR; PG8_MMA(1, 0, At, B0); PG8_MMA(1, 1, At, B1); PG8_BAR; PG8_SCHED;
            PG8_LDB(B0, 1, 0); PG8_LDB(B1, 1, 1); PG8_SCHED; PG8_LDA(At, 1, 0); PG8_STAGE(PG8_SA(0, 1), a2, aC[1]);
            PG8_WAIT_V(8); PG8_WAIT_L(0); PG8_BAR; PG8_MMA(0, 0, At, B0); PG8_MMA(0, 1, At, B1); PG8_BAR; PG8_SCHED;
            PG8_LDA(At, 1, 1); PG8_STAGE(PG8_SB(1, 0), b30, voffB); PG8_STAGE(PG8_SB(1, 1), b30 + bh, voffB); PG8_STAGE(PG8_SA(1, 0), a3, aC[0]);
            PG8_WAIT_V(8); PG8_WAIT_L(0); PG8_BAR; PG8_MMA(1, 0, At, B0); PG8_MMA(1, 1, At, B1); PG8_BAR; PG8_SCHED;
        }
        if (ALIGN) { if (wr == 0) PG8_BAR; }
        { int t2 = tid; asm volatile("" : "+v"(t2));
          E(acc, cur, wr, wc, t2 & 15, (t2 & 63) >> 4); }
        if (!has_next) break;
#pragma unroll
        for (int a = 0; a < 2; ++a)
#pragma unroll
            for (int b = 0; b < 2; ++b)
#pragma unroll
                for (int m = 0; m < 4; ++m)
#pragma unroll
                    for (int n = 0; n < 2; ++n) acc[a][b][m][n] = (f32x4){0.f, 0.f, 0.f, 0.f};
        cur = nxt; cB0 = nB0; ++ui;
        if (ALIGN) { if (wr == 1) PG8_BAR; }
    }
    PG8_WAIT_V(0);
    if (!ALIGN) { if (wr == 0) PG8_BAR; }
    PG8_BAR;
#undef PG8_SA
#undef PG8_SB
#undef PG8_STAGE
#undef PG8_LDA
#undef PG8_LDB
#undef PG8_MMA
#undef PG8_WAIT_V
#undef PG8_WAIT_L
#undef PG8_BAR
#undef PG8_SCHED
#undef PG8_UNIT_ADDR
}
}

namespace att {
using bf16x8 = __attribute__((ext_vector_type(8))) short;
using s16x4 = __attribute__((ext_vector_type(4))) short;
using f32x16 = __attribute__((ext_vector_type(16))) float;
using u32x4 = __attribute__((ext_vector_type(4))) unsigned;
typedef __attribute__((address_space(3))) const char* lds_cptr;
typedef __attribute__((address_space(3))) char* lds_ptr;
typedef short v4i16_t __attribute__((ext_vector_type(4)));
typedef float f32x2_t __attribute__((ext_vector_type(2))); typedef __bf16 bf16x2_t __attribute__((ext_vector_type(2)));
__device__ __forceinline__ int crow(int r, int hi) { return (r & 3) + 8 * (r >> 2) + 4 * hi; }
__device__ __forceinline__ unsigned cvtpk_s(float lo, float hi) { f32x2_t v = {lo, hi}; bf16x2_t b = __builtin_convertvector(v, bf16x2_t); return __builtin_bit_cast(unsigned, b); }
__device__ __forceinline__ void glds16(const void* gsrc, unsigned lds_dst) { unsigned keep;
    asm volatile("s_mov_b32 %0, m0\n\ts_mov_b32 m0, %2\n\ts_nop 0\n\tglobal_load_lds_dwordx4 %1, off\n\ts_mov_b32 m0, %0" : "=&s"(keep) : "v"(gsrc), "s"(lds_dst) : "memory"); }
__device__ __forceinline__ s16x4 vtr(lds_cptr p) { return __builtin_bit_cast(s16x4, __builtin_amdgcn_ds_read_tr16_b64_v4i16((__attribute__((address_space(3))) v4i16_t*)p)); }
#define ATT_WAIT_BAR(N) asm volatile("s_waitcnt vmcnt(" #N ") lgkmcnt(0)\n\ts_barrier" ::: "memory")

struct St { f32x16 o0, o1; float m, l; };
__device__ __forceinline__ float xhalf_max(float v) { auto rr = __builtin_amdgcn_permlane32_swap(__float_as_uint(v), __float_as_uint(v), false, false); return fmaxf(__uint_as_float(rr[0]), __uint_as_float(rr[1])); }
__device__ __forceinline__ float xhalf_sum(float v) { auto rr = __builtin_amdgcn_permlane32_swap(__float_as_uint(v), __float_as_uint(v), false, false); return __uint_as_float(rr[0]) + __uint_as_float(rr[1]); }

__device__ __forceinline__ f32x16 qk32(const bf16x8 (&qr)[4], lds_cptr kimg, const f32x16& c0, int lane) {
    const int r32 = lane & 31, hi = lane >> 5;
    const lds_cptr kr = kimg + r32 * 128; const int y = hi ^ ((r32 >> 1) & 7);
    const bf16x8 k0 = *(const __attribute__((address_space(3))) bf16x8*)(kr + ((0 ^ y) << 4)), k1 = *(const __attribute__((address_space(3))) bf16x8*)(kr + ((2 ^ y) << 4)),
                 k2 = *(const __attribute__((address_space(3))) bf16x8*)(kr + ((4 ^ y) << 4)), k3 = *(const __attribute__((address_space(3))) bf16x8*)(kr + ((6 ^ y) << 4));
    f32x16 p = __builtin_amdgcn_mfma_f32_32x32x16_bf16(k0, qr[0], c0, 0, 0, 0);
    p = __builtin_amdgcn_mfma_f32_32x32x16_bf16(k1, qr[1], p, 0, 0, 0);
    p = __builtin_amdgcn_mfma_f32_32x32x16_bf16(k2, qr[2], p, 0, 0, 0);
    p = __builtin_amdgcn_mfma_f32_32x32x16_bf16(k3, qr[3], p, 0, 0, 0);
    return p;
}
template <int NB>
__device__ __forceinline__ void softmax_upd(St& s, f32x16 (&p)[NB], bf16x8 (&pa)[2 * NB]) {
    float mx = p[0][0];
#pragma unroll
    for (int b = 0; b < NB; ++b)
#pragma unroll
        for (int r = 0; r < 16; ++r) mx = fmaxf(mx, p[b][r]);
    mx = xhalf_max(mx);
    const float mnew = fmaxf(s.m, mx);
    const float f = __builtin_amdgcn_exp2f(s.m - mnew);
    s.m = mnew;
#pragma unroll
    for (int r = 0; r < 16; ++r) { s.o0[r] *= f; s.o1[r] *= f; }
    float sum = 0.f;
#pragma unroll
    for (int b = 0; b < NB; ++b)
#pragma unroll
        for (int r = 0; r < 16; ++r) { p[b][r] = __builtin_amdgcn_exp2f(p[b][r] - mnew); sum += p[b][r]; }
    s.l = s.l * f + sum;
#pragma unroll
    for (int b = 0; b < NB; ++b) { u32x4 w0, w1;
        w0[0] = cvtpk_s(p[b][0], p[b][1]); w0[1] = cvtpk_s(p[b][2], p[b][3]); w0[2] = cvtpk_s(p[b][4], p[b][5]); w0[3] = cvtpk_s(p[b][6], p[b][7]);
        w1[0] = cvtpk_s(p[b][8], p[b][9]); w1[1] = cvtpk_s(p[b][10], p[b][11]); w1[2] = cvtpk_s(p[b][12], p[b][13]); w1[3] = cvtpk_s(p[b][14], p[b][15]);
        pa[2 * b] = __builtin_bit_cast(bf16x8, w0); pa[2 * b + 1] = __builtin_bit_cast(bf16x8, w1); }
}
__device__ __forceinline__ void pv32(St& s, const bf16x8& pa0, const bf16x8& pa1, lds_cptr vimg, int lane) {
    const int hi = lane >> 5;
    const int b1 = (lane >> 3) & 1;
    const lds_cptr vp = vimg + (4 * hi + ((lane & 15) >> 2)) * 128 + ((lane >> 4) & 1) * 32 + (lane & 3) * 8;
    const lds_cptr vpd[2] = {vp + (b1 << 6), vp + ((b1 ^ 1) << 6)};
#define ATT_VF(dh, ks) ({ const s16x4 lo_ = vtr(vpd[dh] + (ks) * 2048), hi_ = vtr(vpd[dh] + (ks) * 2048 + 1024); (bf16x8){lo_[0], lo_[1], lo_[2], lo_[3], hi_[0], hi_[1], hi_[2], hi_[3]}; })
    const bf16x8 v00 = ATT_VF(0, 0), v10 = ATT_VF(1, 0), v01 = ATT_VF(0, 1), v11 = ATT_VF(1, 1);
    s.o0 = __builtin_amdgcn_mfma_f32_32x32x16_bf16(v00, pa0, s.o0, 0, 0, 0);
    s.o1 = __builtin_amdgcn_mfma_f32_32x32x16_bf16(v10, pa0, s.o1, 0, 0, 0);
    s.o0 = __builtin_amdgcn_mfma_f32_32x32x16_bf16(v01, pa1, s.o0, 0, 0, 0);
    s.o1 = __builtin_amdgcn_mfma_f32_32x32x16_bf16(v11, pa1, s.o1, 0, 0, 0);
#undef ATT_VF
}

template <class RowPtr>
__device__ __forceinline__ void finish(St& s, __attribute__((address_space(3))) bf16* stg, int lane, const RowPtr& rowptr) {
    const int r32 = lane & 31, hi = lane >> 5;
    s.l = xhalf_sum(s.l);
    const float il = __builtin_amdgcn_rcpf(s.l);
    typedef unsigned u32x2 __attribute__((ext_vector_type(2)));
#pragma unroll
    for (int g = 0; g < 4; ++g) {
        u32x2 w0, w1;
        w0[0] = cvtpk_s(s.o0[4 * g] * il, s.o0[4 * g + 1] * il); w0[1] = cvtpk_s(s.o0[4 * g + 2] * il, s.o0[4 * g + 3] * il);
        w1[0] = cvtpk_s(s.o1[4 * g] * il, s.o1[4 * g + 1] * il); w1[1] = cvtpk_s(s.o1[4 * g + 2] * il, s.o1[4 * g + 3] * il);
        *(__attribute__((address_space(3))) u32x2*)(stg + r32 * 64 + 8 * g + 4 * hi) = w0;
        *(__attribute__((address_space(3))) u32x2*)(stg + r32 * 64 + 32 + 8 * g + 4 * hi) = w1; }
    asm volatile("s_waitcnt lgkmcnt(0)" ::: "memory");
#pragma unroll
    for (int i = 0; i < 4; ++i) { const int row = i * 8 + (lane >> 3), ch = lane & 7; const u32x4 v = *(const __attribute__((address_space(3))) u32x4*)(stg + row * 64 + ch * 8);
        __builtin_nontemporal_store(v, (u32x4*)(rowptr(row) + ch * 8)); }
    asm volatile("s_waitcnt lgkmcnt(0)" ::: "memory");
}

template <int NB>
__device__ __forceinline__ void att_step(St& s, float& ref, float& fprev, const bf16x8 (&qr)[4], lds_cptr kimg, lds_cptr vimg, unsigned bw0, unsigned bw1, const f32x16& c0, const f32x16& c1, int lane) {
    const int hi = lane >> 5;
    const unsigned one2 = 0x3f803f80u;
    const unsigned nrh = f2bf(-ref); const unsigned nrl = f2bf(-ref - __uint_as_float(nrh << 16));
    u32x4 qxw = {one2, nrh | (nrl << 16), 0u, 0u}; u32x4 kx0w = {bw0, one2, 0u, 0u}; u32x4 kx1w = {bw1, one2, 0u, 0u};
    if (hi) { qxw = (u32x4){0u, 0u, 0u, 0u}; kx0w = qxw; kx1w = qxw; }
    const bf16x8 qx = __builtin_bit_cast(bf16x8, qxw), kx0 = __builtin_bit_cast(bf16x8, kx0w), kx1 = __builtin_bit_cast(bf16x8, kx1w);
    f32x16 p[NB];
    p[0] = qk32(qr, kimg, c0, lane); if (NB == 2) p[NB - 1] = qk32(qr, kimg + 4096, c1, lane);
    p[0] = __builtin_amdgcn_mfma_f32_32x32x16_bf16(kx0, qx, p[0], 0, 0, 0);
    if (NB == 2) p[NB - 1] = __builtin_amdgcn_mfma_f32_32x32x16_bf16(kx1, qx, p[NB - 1], 0, 0, 0);
#pragma unroll
    for (int r = 0; r < 16; ++r) { s.o0[r] *= fprev; s.o1[r] *= fprev; }
    float mx = p[0][0];
#pragma unroll
    for (int b = 0; b < NB; ++b)
#pragma unroll
        for (int r = 0; r < 16; ++r) mx = fmaxf(mx, p[b][r]);
    mx = xhalf_max(mx);
    float sum = 0.f;
#pragma unroll
    for (int b = 0; b < NB; ++b)
#pragma unroll
        for (int r = 0; r < 16; ++r) { p[b][r] = __builtin_amdgcn_exp2f(p[b][r]); sum += p[b][r]; }
    s.l = s.l * fprev + sum;
    const float d = fmaxf(mx, 0.f); ref += d; fprev = __builtin_amdgcn_exp2f(-d);
    bf16x8 pa[2 * NB];
#pragma unroll
    for (int b = 0; b < NB; ++b) { u32x4 w0, w1;
        w0[0] = cvtpk_s(p[b][0], p[b][1]); w0[1] = cvtpk_s(p[b][2], p[b][3]); w0[2] = cvtpk_s(p[b][4], p[b][5]); w0[3] = cvtpk_s(p[b][6], p[b][7]);
        w1[0] = cvtpk_s(p[b][8], p[b][9]); w1[1] = cvtpk_s(p[b][10], p[b][11]); w1[2] = cvtpk_s(p[b][12], p[b][13]); w1[3] = cvtpk_s(p[b][14], p[b][15]);
        pa[2 * b] = __builtin_bit_cast(bf16x8, w0); pa[2 * b + 1] = __builtin_bit_cast(bf16x8, w1); }
    pv32(s, pa[0], pa[1], vimg, lane); if (NB == 2) pv32(s, pa[2 * NB - 2], pa[2 * NB - 1], vimg + 4096, lane);
}

constexpr int L_K = 0, L_V = 49152;
constexpr int FOX_SLOT = 16384;
constexpr int L_KB = 49152;
constexpr int L_RED = 65536;
constexpr int L_WSF = 98304;
constexpr int L_OST = 100352;
constexpr int L_END = L_OST + 32768;

struct DilU { int b, h, br, rr, rho, j; };
__device__ __forceinline__ DilU dil_decode(int u) {
    DilU d; const int bh = u / 48, r = u % 48; d.b = bh / 12; d.h = bh % 12;
    if (r < 16) { d.br = 0; d.rr = 1; d.rho = 0; d.j = r; } else if (r < 32) { d.br = 1; d.rr = 4; d.rho = (r - 16) >> 2; d.j = (r - 16) & 3; } else { d.br = 2; d.rr = 16; d.rho = r - 32; d.j = 0; }
    return d;
}
__device__ __forceinline__ void dil_issue(const DilU& u, const bf16* Z, int tid, u32x4 (&kv)[12], u32x4 (&qv)[4]) {
    const size_t hb = ((size_t)(u.b * HD_DIL + u.h) * S) * 64;
    const int e0 = 256 * u.j - 128, c = tid & 7;
    const bf16* r0 = Z + hb + (size_t)u.rho * 64 + c * 8;
    const ptrdiff_t est = (ptrdiff_t)u.rr * 64;
    const bf16* rp = r0 + (ptrdiff_t)(e0 + (tid >> 3)) * est;
#pragma unroll
    for (int i = 0; i < 6; ++i) { const bf16* p = (u.j == 0 && i < 2) ? r0 : rp + (ptrdiff_t)(64 * i) * est;
        kv[i] = *(const u32x4*)(p + RKA); kv[6 + i] = *(const u32x4*)(p + RVA); }
    const bf16* qp = rp + (ptrdiff_t)128 * est + RQA;
#pragma unroll
    for (int i = 0; i < 4; ++i) qv[i] = *(const u32x4*)(qp + (ptrdiff_t)(64 * i) * est);
}
__device__ __forceinline__ void dil_commit(char* shm, int tid, const u32x4 (&kv)[12], const u32x4 (&qv)[4]) {
    const lds_ptr base = (lds_ptr)shm; const int c = tid & 7;
#pragma unroll
    for (int i = 0; i < 6; ++i) { const int row = (tid >> 3) + 64 * i;
        *(__attribute__((address_space(3))) u32x4*)(base + L_K + row * 128 + ((c ^ ((row >> 1) & 7)) << 4)) = kv[i];
        *(__attribute__((address_space(3))) u32x4*)(base + L_V + row * 128 + ((c ^ (((row >> 1) & 1) << 2)) << 4)) = kv[6 + i]; }
#pragma unroll
    for (int i = 0; i < 4; ++i) { const int row = (tid >> 3) + 64 * i;
        *(__attribute__((address_space(3))) u32x4*)(base + L_OST + row * 128 + ((c ^ ((row >> 1) & 7)) << 4)) = qv[i]; }
}
__device__ __forceinline__ void dil_qfrag(char* shm, int tid, bf16x8 (&qr)[4]) {
    const int lane = tid & 63, r32 = lane & 31, hi = lane >> 5, wid = tid >> 6; const int y = hi ^ ((r32 >> 1) & 7);
    const lds_cptr qrow = (lds_cptr)shm + L_OST + (32 * wid + r32) * 128;
#pragma unroll
    for (int d0 = 0; d0 < 4; ++d0) qr[d0] = *(const __attribute__((address_space(3))) bf16x8*)(qrow + (((2 * d0) ^ y) << 4));
}
template <int LITE = 0>
__device__ __forceinline__ void dil_compute(const DilU& u, const bf16x8 (&qr)[4], bf16* OP, float* ML, char* shm, int tid, const float bk2) {
    const int lane = tid & 63, r32 = lane & 31, hi = lane >> 5; const int wid = __builtin_amdgcn_readfirstlane(tid >> 6);
    const lds_cptr shm3 = (lds_cptr)shm;
    __attribute__((address_space(3))) bf16* stg = (__attribute__((address_space(3))) bf16*)(shm3 + L_OST) + wid * 2048;
    const lds_cptr kw = shm3 + L_K + 32 * wid * 128, vw = shm3 + L_V + 32 * wid * 128;
    const int nlive0 = (u.j == 0) ? 4 - wid : 0;
    float qs = 0.f;
#pragma unroll
    for (int d0 = 0; d0 < 4; ++d0) { const u32x4 w = __builtin_bit_cast(u32x4, qr[d0]);
#pragma unroll
        for (int j = 0; j < 4; ++j) { const float lo = __uint_as_float(w[j] << 16), hi_ = __uint_as_float(w[j] & 0xffff0000u); qs += lo * lo + hi_ * hi_; } }
    qs = xhalf_sum(qs);
    const bool fast = !__any(!(qs * bk2 * 1.05f <= 4096.f));
    St s; s.o0 = f32x16{}; s.o1 = f32x16{}; s.m = 0.f; s.l = 0.f;
    float mref = 0.f, lscale = 1.f;
    if (LITE == 1) { } else
    if (fast) {
#pragma unroll
        for (int b = 0; b < 5; ++b) {
            if (b < nlive0) continue;
            f32x16 c;
#pragma unroll
            for (int r = 0; r < 16; ++r) c[r] = (b == 0 && r32 > crow(r, hi)) || (b == 4 && r32 < crow(r, hi)) ? -INFINITY : 0.f;
            f32x16 p = qk32(qr, kw + b * 4096, c, lane);
            float sum = 0.f;
#pragma unroll
            for (int r = 0; r < 16; ++r) { p[r] = __builtin_amdgcn_exp2f(p[r]); sum += p[r]; }
            s.l += sum;
            u32x4 w0, w1;
            w0[0] = cvtpk_s(p[0], p[1]); w0[1] = cvtpk_s(p[2], p[3]); w0[2] = cvtpk_s(p[4], p[5]); w0[3] = cvtpk_s(p[6], p[7]);
            w1[0] = cvtpk_s(p[8], p[9]); w1[1] = cvtpk_s(p[10], p[11]); w1[2] = cvtpk_s(p[12], p[13]); w1[3] = cvtpk_s(p[14], p[15]);
            pv32(s, __builtin_bit_cast(bf16x8, w0), __builtin_bit_cast(bf16x8, w1), vw + b * 4096, lane);
        }
    } else {
        float ref = sqrtf(qs * bk2 * 1.05f), fprev = 1.f;
#pragma nounroll
        for (int kbi = nlive0; kbi < 5; ++kbi) {
            f32x16 c;
#pragma unroll
            for (int r = 0; r < 16; ++r) c[r] = (kbi == 0 && r32 > crow(r, hi)) || (kbi == 4 && r32 < crow(r, hi)) ? -INFINITY : 0.f;
            att_step<1>(s, ref, fprev, qr, kw + kbi * 4096, vw + kbi * 4096, 0u, 0u, c, c, lane);
        }
        mref = ref; lscale = fprev;
    }
    bf16* OPb = OP + ((size_t)u.br * T + (size_t)u.b * S) * 768 + u.h * 64;
    const int eb = 256 * u.j + 32 * wid;
    finish(s, stg, lane, [&](int q) { return OPb + (size_t)(u.rho + u.rr * (eb + q)) * 768; });
    if (hi == 0) { const int tq = u.rho + u.rr * (eb + r32); float* mp = ML + (((size_t)u.br * T + (size_t)u.b * S + tq) * 12 + u.h) * 2; mp[0] = mref; mp[1] = s.l * lscale; }
}

__device__ __forceinline__ void fox_bias(int b, int h, int n, const float* logf, char* shm, const int tid) {
    const int lane = tid & 63, wid = tid >> 6;
    __attribute__((address_space(3))) float* kb = (__attribute__((address_space(3))) float*)((lds_cptr)shm + L_KB);
    __attribute__((address_space(3))) float* red = (__attribute__((address_space(3))) float*)((lds_cptr)shm + L_RED);
    float v[8]; float tot = 0.f;
#pragma unroll
    for (int i = 0; i < 8; ++i) { const int sidx = tid * 8 + i; v[i] = sidx < n ? logf[((size_t)b * S + sidx) * 4 + h] : 0.f; tot += v[i]; v[i] = tot; }
    float inc = tot;
#pragma unroll
    for (int o = 1; o < 64; o <<= 1) { const float x = __shfl_up(inc, o); if (lane >= o) inc += x; }
    if (lane == 63) red[wid] = inc;
    __syncthreads();
    float base = inc - tot;
    for (int w = 0; w < wid; ++w) base += red[w];
#pragma unroll
    for (int i = 0; i < 8; ++i) { const float bv = -(base + v[i]) * LOG2E; const unsigned bh = f2bf(bv); const unsigned bl = f2bf(bv - __uint_as_float(bh << 16));
        kb[tid * 8 + i] = __uint_as_float(bh | (bl << 16)); }
    __syncthreads();
}

template <bool DIAG>
__device__ __forceinline__ void fox_tile(St& s, float& ref, float& fprev, const bf16x8 (&qr)[4], lds_cptr kimg, lds_cptr vimg, lds_cptr kbias_t, int qrel  , const f32x16& zero16, int lane) {
    const int r32 = lane & 31, hi = lane >> 5;
    const unsigned bw0 = __float_as_uint(*(const __attribute__((address_space(3))) float*)(kbias_t + r32 * 4)), bw1 = __float_as_uint(*(const __attribute__((address_space(3))) float*)(kbias_t + (32 + r32) * 4));
    f32x16 c0 = zero16, c1 = zero16;
    if (DIAG) {
#pragma unroll
        for (int r = 0; r < 16; ++r) { const int k = crow(r, hi); c0[r] = k > qrel ? -INFINITY : 0.f; c1[r] = k + 32 > qrel ? -INFINITY : 0.f; }
    }
    att_step<2>(s, ref, fprev, qr, kimg, vimg, bw0, bw1, c0, c1, lane);
}
__device__ __forceinline__ void fox_unit(int b, int h, int qb, const bf16* Z, bf16* OF, char* shm, const int tid, const float bk2) {
    const int lane = tid & 63, r32 = lane & 31, hi = lane >> 5; const int wid = __builtin_amdgcn_readfirstlane(tid >> 6);
    const unsigned lds0 = (unsigned)(uintptr_t)shm;
    const lds_cptr shm3 = (lds_cptr)shm;
    __attribute__((address_space(3))) bf16* stg = (__attribute__((address_space(3))) bf16*)(shm3 + L_OST) + wid * 2048;
    const lds_cptr kbias = shm3 + L_KB;
    const size_t hb = ((size_t)(b * HD_FOX + h) * S) * 64;
    const int q0 = qb * 256;
    const int NTw = (q0 + 32 * wid) / 64 + 1;
    const int NT = (q0 + 256) / 64;
    const int drow = 8 * wid + (lane >> 3);
    const bf16* ksrc = Z + RKF + hb + (size_t)drow * 64 + (((lane & 7) ^ ((drow >> 1) & 7)) << 3);
    const bf16* vsrc = Z + RVF + hb + (size_t)drow * 64 + (((lane & 7) ^ (((drow >> 1) & 1) << 2)) << 3);
    const unsigned kdst = lds0 + L_K + wid * 1024, vdst = lds0 + L_K + 8192 + wid * 1024;
#define FOX_DMA(t, slot) do { glds16(ksrc + (size_t)(t) * 64 * 64, (unsigned)__builtin_amdgcn_readfirstlane(kdst + (slot) * FOX_SLOT)); \
                              glds16(vsrc + (size_t)(t) * 64 * 64, (unsigned)__builtin_amdgcn_readfirstlane(vdst + (slot) * FOX_SLOT)); } while (0)
    const int qrow = q0 + 32 * wid + r32;
    bf16x8 qr[4];
#pragma unroll
    for (int d0 = 0; d0 < 4; ++d0) qr[d0] = *(const bf16x8*)(Z + RQF + hb + (size_t)qrow * 64 + d0 * 16 + hi * 8);
    int t0; float ref0;
    { float qs = 0.f;
#pragma unroll
      for (int d0 = 0; d0 < 4; ++d0) { const u32x4 w = __builtin_bit_cast(u32x4, qr[d0]);
#pragma unroll
          for (int j = 0; j < 4; ++j) { const float lo = __uint_as_float(w[j] << 16), hi_ = __uint_as_float(w[j] & 0xffff0000u); qs += lo * lo + hi_ * hi_; } }
      qs = xhalf_sum(qs);
#pragma unroll
      for (int o = 1; o < 32; o <<= 1) qs = fmaxf(qs, __shfl_xor(qs, o));
      __attribute__((address_space(3))) float* red = (__attribute__((address_space(3))) float*)(shm3 + L_RED);
      if (lane == 0) red[wid] = qs;
      asm volatile("s_waitcnt lgkmcnt(0)\n\ts_barrier" ::: "memory");
      float bq2 = red[0];
#pragma unroll
      for (int w = 1; w < 8; ++w) bq2 = fmaxf(bq2, red[w]);
      const float th = 64.f + 2.05f * sqrtf(bq2 * bk2) + 2.f;
      const float* kbf = (const float*)0; (void)kbf;
      auto kbv = [&](int key) { const unsigned w = __float_as_uint(*(const __attribute__((address_space(3))) float*)(kbias + key * 4)); return __uint_as_float(w << 16) + __uint_as_float(w & 0xffff0000u); };
      const float kq0 = kbv(q0);
      t0 = 0;
      while (t0 < 4 * qb && kq0 - kbv(64 * t0 + 63) > th) ++t0;
      t0 = __builtin_amdgcn_readfirstlane(t0);
#ifdef FOX_NOPRUNE
      t0 = 0;
#endif
#ifdef FOX_FORCE2
      t0 = 4 * qb < 2 ? 4 * qb : 2;
#endif
      ref0 = kbv(64 * t0);
      asm volatile("s_waitcnt lgkmcnt(0)\n\ts_barrier" ::: "memory");
    }
    FOX_DMA(t0, 0); if (t0 + 1 < NT) FOX_DMA(t0 + 1, 1);
    St s; s.o0 = f32x16{}; s.o1 = f32x16{}; s.m = 0.f; s.l = 0.f;
    float ref = ref0, fprev = 1.f;
    f32x16 zero16 = f32x16{}; asm volatile("" : "+v"(zero16));
    asm volatile("" : "+v"(qr[0]), "+v"(qr[1]), "+v"(qr[2]), "+v"(qr[3]));
    asm volatile("s_waitcnt vmcnt(0)" ::: "memory");
    int slot = 0;
    for (int t = t0; t < NT; ++t) {
        if (t + 1 < NT && t > t0) { ATT_WAIT_BAR(2); } else { ATT_WAIT_BAR(0); }
        if (t + 2 < NT) { const int s2 = slot == 0 ? 2 : slot - 1; FOX_DMA(t + 2, s2); }
        const lds_cptr kt = shm3 + L_K + slot * FOX_SLOT, vt = kt + 8192;
        if (t < NTw - 1) fox_tile<false>(s, ref, fprev, qr, kt, vt, kbias + 64 * t * 4, 0, zero16, lane);
        else if (t == NTw - 1) fox_tile<true>(s, ref, fprev, qr, kt, vt, kbias + 64 * t * 4, qrow - 64 * t, zero16, lane);
        slot = slot == 2 ? 0 : slot + 1;
    }
#undef FOX_DMA
    bf16* OFb = OF + ((size_t)b * S + q0 + 32 * wid) * 256 + h * 64;
    finish(s, stg, lane, [&](int q) { return OFb + (size_t)q * 256; });
    asm volatile("s_waitcnt lgkmcnt(0)\n\ts_barrier" ::: "memory");
}
}

constexpr int NWAVES = 8;
constexpr int RING_BYTES = 131072;
constexpr int MISC_OFF = pg8::ETAB_OFF + 256;
constexpr int LDS_BYTES = 147456;
static_assert(MISC_OFF + 256 <= LDS_BYTES && att::L_END <= MISC_OFF, "LDS map");

#define GAS __attribute__((address_space(1)))
#define LAS __attribute__((address_space(3)))
#include <type_traits>
typedef unsigned v4u __attribute__((ext_vector_type(4)));
typedef float f32x4 __attribute__((ext_vector_type(4)));
typedef GAS unsigned gu32;
#define RLX_AGENT __ATOMIC_RELAXED, __HIP_MEMORY_SCOPE_AGENT
#define LDS_WAIT() asm volatile("s_waitcnt lgkmcnt(0)" ::: "memory")

#define XB_TMO      128
#define XB_XCNT(j)  (256  + 64 * (j))
#define XB_XSUB(j)  (1280 + 64 * (j))
#define XB_XGEN(j)  (2304 + 64 * (j))
#define XB_TOP      3328
#define XB_TOPGEN   3392
#define XCD_BAR_WORDS 3456
#define XB_SPIN_CAP (1u << 20)
__device__ __forceinline__ unsigned xb_ld(unsigned* p)              { return __hip_atomic_load(p, __ATOMIC_RELAXED, __HIP_MEMORY_SCOPE_AGENT); }
__device__ __forceinline__ unsigned xb_add(unsigned* p, unsigned v) { return __hip_atomic_fetch_add(p, v, __ATOMIC_RELAXED, __HIP_MEMORY_SCOPE_AGENT); }
__device__ __forceinline__ unsigned xb_xcc_id() { return (unsigned)__builtin_amdgcn_s_getreg((3 << 11) | 20) & 0xFu; }
#define XB_SPIN(cond, bar) do { unsigned _sp = 0; while (cond) { __builtin_amdgcn_s_sleep(1); \
    if ((++_sp & 255u) == 0u) { if (xb_ld(&(bar)[XB_TMO])) break; if (_sp > XB_SPIN_CAP) { atomicAdd(&(bar)[XB_TMO], 1u); break; } } } } while (0)
struct XcdBarrier { unsigned* bar; unsigned x; volatile LAS unsigned* st; };
__device__ __forceinline__ XcdBarrier xcd_barrier_post(unsigned* bar, volatile LAS unsigned* st, bool t0) {
    XcdBarrier b; b.bar = bar; b.x = xb_xcc_id(); b.st = st;
    if (t0) (void)xb_add(&bar[XB_XCNT(b.x)], 1u);
    return b;
}
__device__ __forceinline__ void xcd_barrier_complete(unsigned* bar, unsigned x, unsigned& nloc, unsigned& nx) {
    const unsigned G = gridDim.x * gridDim.y * gridDim.z;
    unsigned sum, cnt, mine, sp = 0u;
    for (;;) {
        sum = 0u; cnt = 0u; mine = 0u;
#pragma unroll
        for (unsigned j = 0; j < 16; ++j) { const unsigned c = xb_ld(&bar[XB_XCNT(j)]); sum += c; cnt += (c > 0u) ? 1u : 0u; mine = (j == x) ? c : mine; }
        if (sum == G) break;
        __builtin_amdgcn_s_sleep(1);
        if ((++sp & 255u) == 0u) { if (xb_ld(&bar[XB_TMO])) break; if (sp > XB_SPIN_CAP) { atomicAdd(&bar[XB_TMO], 1u); break; } }
    }
    nloc = mine > 0u ? mine : 1u; nx = cnt > 0u ? cnt : 1u;
}
__device__ __forceinline__ void xcd_barrier(const XcdBarrier& b, bool t0) {
    asm volatile("s_waitcnt vmcnt(0)" ::: "memory");
    __syncthreads();
    if (t0) {
        unsigned* bar = b.bar;
        __builtin_amdgcn_s_waitcnt(0);
        unsigned nloc = b.st[0], nx = b.st[1];
        if (nloc == 0u) { xcd_barrier_complete(bar, b.x, nloc, nx); b.st[0] = nloc; b.st[1] = nx; }
        const unsigned old = xb_add(&bar[XB_XSUB(b.x)], 1u);
        const unsigned gen = old / nloc;
        if (old + 1u == (gen + 1u) * nloc) {
            __builtin_amdgcn_fence(__ATOMIC_RELEASE, "agent");
            asm volatile("s_waitcnt vmcnt(0)" ::: "memory");
            const unsigned og = xb_add(&bar[XB_TOP], 1u);
            const unsigned tg = og / nx; const bool lastx = (og + 1u == (tg + 1u) * nx);
            asm volatile("buffer_inv sc1" ::: "memory");
            if (lastx) xb_add(&bar[XB_TOPGEN], 1u);
            else XB_SPIN(xb_ld(&bar[XB_TOPGEN]) == tg, bar);
            asm volatile("s_waitcnt vmcnt(0)" ::: "memory");
        } else {
            asm volatile("buffer_inv sc1" ::: "memory");
            XB_SPIN(xb_ld(&bar[XB_TOPGEN]) == gen, bar);
            asm volatile("s_waitcnt vmcnt(0)" ::: "memory");
        }
    }
    __syncthreads();
}

__device__ __forceinline__ int fresh_lane() { int l; asm volatile("v_mbcnt_lo_u32_b32 %0, -1, 0\n\tv_mbcnt_hi_u32_b32 %0, -1, %0" : "=v"(l)); return l; }
struct Args { const float* in[15]; float* out; unsigned char* ws; int ph_lo, ph_hi, li, pad; };
struct Frame { LAS unsigned char* lds; int tid, lane, wave, G, gw, NGW; };

template <int CTRL, int ROWMASK> __device__ __forceinline__ float dpp_mov(float v) { return __int_as_float(__builtin_amdgcn_update_dpp(0, __float_as_int(v), CTRL, ROWMASK, 0xF, false)); }
__device__ __forceinline__ float wave_sum(float v) {
    v += dpp_mov<0xB1, 0xF>(v);
    v += dpp_mov<0x4E, 0xF>(v);
    v += dpp_mov<0x141, 0xF>(v);
    v += dpp_mov<0x140, 0xF>(v);
    v += dpp_mov<0x142, 0xA>(v);
    v += dpp_mov<0x143, 0xC>(v);
    return __int_as_float(__builtin_amdgcn_readlane(__float_as_int(v), 63));
}
__device__ __forceinline__ void unpack8(v4u v, float* o) {
    o[0] = __uint_as_float(v.x << 16); o[1] = __uint_as_float(v.x & 0xffff0000u); o[2] = __uint_as_float(v.y << 16); o[3] = __uint_as_float(v.y & 0xffff0000u);
    o[4] = __uint_as_float(v.z << 16); o[5] = __uint_as_float(v.z & 0xffff0000u); o[6] = __uint_as_float(v.w << 16); o[7] = __uint_as_float(v.w & 0xffff0000u);
}
__device__ __forceinline__ v4u pack8(const float* o) { v4u v; v.x = pk2(o[0], o[1]); v.y = pk2(o[2], o[3]); v.z = pk2(o[4], o[5]); v.w = pk2(o[6], o[7]); return v; }

__device__ __forceinline__ void tr_load_tile(const float* W, int ldw, int k0, int n0s, LAS float* scr, int lane, float wsc) {
    const int g = lane & 7, kr = lane >> 3; f32x4 wv[8];
    const float* wp = W + (size_t)(k0 + kr) * ldw + n0s + 4 * g;
#pragma unroll
    for (int i = 0; i < 8; ++i) wv[i] = *(const GAS f32x4*)(wp + (size_t)(8 * i) * ldw);
#pragma unroll
    for (int i = 0; i < 8; ++i) *(LAS f32x4*)(scr + (8 * i + kr) * 32 + 4 * (g ^ i)) = wv[i] * wsc;
    LDS_WAIT(); asm volatile("" ::: "memory");
}
__device__ __forceinline__ void tr_item(const float* W, int ldw, int k0, int n0s, bf16* WT, int K, int n0d, LAS float* scr, int lane, float wsc = 1.f) {
    tr_load_tile(W, ldw, k0, n0s, scr, lane, wsc);
    const int c = lane & 7;
#pragma unroll
    for (int j = 0; j < 4; ++j) { const int n = (lane >> 3) + 8 * j; const LAS float* s = scr + (8 * c) * 32 + 4 * ((n >> 2) ^ c) + (n & 3);
        v4u o; o.x = pk2(s[0 * 32], s[1 * 32]); o.y = pk2(s[2 * 32], s[3 * 32]); o.z = pk2(s[4 * 32], s[5 * 32]); o.w = pk2(s[6 * 32], s[7 * 32]);
        *(GAS v4u*)(WT + (size_t)(n0d + n) * K + k0 + 8 * c) = o; }
    LDS_WAIT(); asm volatile("" ::: "memory");
}
__device__ __forceinline__ void tr_item8(const float* W, int ldw, int k0, int n0s, unsigned char* WT, int K, int n0d, LAS float* scr, int lane) {
    typedef unsigned u32x2 __attribute__((ext_vector_type(2)));
    tr_load_tile(W, ldw, k0, n0s, scr, lane, 32.f);
    const int c = lane & 7;
#pragma unroll
    for (int j = 0; j < 4; ++j) { const int n = (lane >> 3) + 8 * j; const LAS float* s = scr + (8 * c) * 32 + 4 * ((n >> 2) ^ c) + (n & 3);
        int w0 = 0, w1 = 0;
        w0 = __builtin_amdgcn_cvt_pk_fp8_f32(s[0 * 32], s[1 * 32], w0, false); w0 = __builtin_amdgcn_cvt_pk_fp8_f32(s[2 * 32], s[3 * 32], w0, true);
        w1 = __builtin_amdgcn_cvt_pk_fp8_f32(s[4 * 32], s[5 * 32], w1, false); w1 = __builtin_amdgcn_cvt_pk_fp8_f32(s[6 * 32], s[7 * 32], w1, true);
        *(GAS u32x2*)(WT + (size_t)(n0d + n) * K + k0 + 8 * c) = (u32x2){(unsigned)w0, (unsigned)w1}; }
    LDS_WAIT(); asm volatile("" ::: "memory");
}
__device__ __forceinline__ void conv_expert_mat8(const Frame& F, const float* Wl, unsigned char* WTl) {
    LAS float* scr = (LAS float*)(F.lds + F.wave * 16384);
    constexpr int PER_E = 16 * 32, NIT = NE * PER_E;
    for (int it = F.gw; it < NIT; it += F.NGW) {
        const int e = it / PER_E, q = it % PER_E, kb = q / 32, nb = q % 32;
        tr_item8(Wl + (size_t)e * D * D, D, 64 * kb, 32 * nb, WTl + (size_t)e * D * D, D, 32 * nb, scr, F.lane);
    }
}
constexpr int CQ_NCH = 3 * NE * 16 * 32 / 16;
__device__ __forceinline__ void conv_chunk8(const Frame& F, const float* wg, const float* wu, const float* wd, unsigned char* dst  , int chunk) {
    LAS float* scr = (LAS float*)(F.lds + F.wave * 16384);
#pragma unroll 1
    for (int j = 0; j < 2; ++j) {
        const int it = 16 * chunk + 8 * j + F.wave, mat = it >> 13, r = it & 8191, e = r >> 9, q = r & 511, kb = q >> 5, nb = q & 31;
        const float* W = (mat == 0 ? wg : mat == 1 ? wu : wd) + (size_t)e * D * D;
        tr_item8(W, D, 64 * kb, 32 * nb, dst + (size_t)mat * (16 * MiB) + (size_t)e * D * D, D, 32 * nb, scr, F.lane);
    }
}
__device__ __forceinline__ void conv_pull(const Frame& F, const float* wg, const float* wu, const float* wd, unsigned char* dst, int* cq, int n) {
    LAS int* mb = (LAS int*)(F.lds + MISC_OFF + 64);
    const bool t0 = F.tid == 0;
    __syncthreads();
    if (t0) { mb[0] = n > 0 ? atomicAdd(cq, 1) : CQ_NCH; mb[1] = n > 1 ? atomicAdd(cq, 1) : CQ_NCH; }
    __syncthreads();
    int cur = mb[0], nxt = mb[1];
#pragma unroll 1
    for (int i = 0; cur < CQ_NCH; ++i) {
        int fut = CQ_NCH; if (t0 && i + 2 < n) fut = atomicAdd(cq, 1);
        conv_chunk8(F, wg, wu, wd, dst, cur);
        if (t0) mb[2 + (i & 1)] = fut;
        __syncthreads();
        cur = nxt; nxt = mb[2 + (i & 1)];
    }
    __syncthreads();
}
__device__ __forceinline__ void conv_expert_mat(const Frame& F, const float* Wl, bf16* WTl) {
    LAS float* scr = (LAS float*)(F.lds + F.wave * 16384);
    constexpr int PER_E = 16 * 32, NIT = NE * PER_E;
    for (int it = F.gw; it < NIT; it += F.NGW) {
        const int e = it / PER_E, q = it % PER_E, kb = q / 32, nb = q % 32;
        tr_item(Wl + (size_t)e * D * D, D, 64 * kb, 32 * nb, WTl + (size_t)e * D * D, D, 32 * nb, scr, F.lane);
    }
}
__device__ __forceinline__ void p_prologue(const Frame& F, const float* x, const float* w_in, const float* w_out, bf16* WinT, bf16* WoutT, bf16* H0, bf16* H1, const float* bf0, float* logf) {
    LAS float* scr = (LAS float*)(F.lds + F.wave * 16384);
    for (int it = F.gw; it < 2 * 16 * 96; it += F.NGW) {
        const int l = it / (16 * 96), r = it % (16 * 96), kb = r / 96, nb = r % 96, n0d = 32 * nb, pn = n0d >> 8, bj = (n0d >> 7) & 1, c0 = n0d & 127;
        const int n0s = pn < 6 ? 256 * pn + 64 * (c0 >> 5) + 32 * bj : n0d;
        tr_item(w_in + (size_t)l * D * NPROJ, NPROJ, 64 * kb, n0s, WinT + (size_t)l * NZ * D, D, n0d, scr, F.lane, (pn < 3 || pn == 9) ? C2 : 1.f);
    }
    for (int it = F.gw; it < 2 * 16 * 32; it += F.NGW) {
        const int l = it / (16 * 32), r = it % (16 * 32), kb = r / 32, nb = r % 32;
        tr_item(w_out + (size_t)l * D * D, D, 64 * kb, 32 * nb, WoutT + (size_t)l * D * D, D, 32 * nb, scr, F.lane);
    }
    __syncthreads();
    { LAS float* wfl = (LAS float*)F.lds;
      for (int k = F.tid; k < D; k += 512) { const f32x4 w = *(const GAS f32x4*)(w_in + (size_t)k * NPROJ + NZ); wfl[k] = w.x; wfl[D + k] = w.y; wfl[2 * D + k] = w.z; wfl[3 * D + k] = w.w; }
      __syncthreads();
      f32x4 xv[2][4];
#define PRO_LOAD(slot_, m_) do { const GAS f32x4* xr_ = (const GAS f32x4*)(x + (size_t)(m_) * D) + F.lane; _Pragma("unroll") for (int j = 0; j < 4; ++j) xv[slot_][j] = xr_[64 * j]; } while (0)
      if (F.gw < T) PRO_LOAD(0, F.gw);
      if (F.gw + F.NGW < T) PRO_LOAD(1, F.gw + F.NGW);
      int par = 0;
      for (int m = F.gw; m < T; m += F.NGW, par ^= 1) {
        GAS unsigned long long* o8 = (GAS unsigned long long*)(H0 + (size_t)m * D) + F.lane;
        float acc[4] = {0.f, 0.f, 0.f, 0.f};
        f32x4 cv[4];
        if (par == 0) { _Pragma("unroll") for (int j = 0; j < 4; ++j) cv[j] = xv[0][j]; if (m + 2 * F.NGW < T) PRO_LOAD(0, m + 2 * F.NGW); }
        else { _Pragma("unroll") for (int j = 0; j < 4; ++j) cv[j] = xv[1][j]; if (m + 2 * F.NGW < T) PRO_LOAD(1, m + 2 * F.NGW); }
#pragma unroll
        for (int j = 0; j < 4; ++j) { const f32x4 v = cv[j]; o8[64 * j] = (unsigned long long)pk2(v.x, v.y) | ((unsigned long long)pk2(v.z, v.w) << 32);
#pragma unroll
            for (int q = 0; q < 4; ++q) { const f32x4 w = *(const LAS f32x4*)(wfl + q * D + 4 * F.lane + 256 * j); acc[q] += v.x * w.x + v.y * w.y + v.z * w.z + v.w * w.w; } }
#pragma unroll
        for (int q = 0; q < 4; ++q) acc[q] = wave_sum(acc[q]);
        if (F.lane < 4) { const float z = (F.lane == 0 ? acc[0] : F.lane == 1 ? acc[1] : F.lane == 2 ? acc[2] : acc[3]) + bf0[F.lane];
            logf[(size_t)m * 4 + F.lane] = fminf(z, 0.f) - log1pf(expf(-fabsf(z))); }
      }
    }
    if (blockIdx.x == 0) { for (int i = F.tid; i < D; i += 512) { H0[(size_t)T * D + i] = 0; H1[(size_t)T * D + i] = 0; } }
    __syncthreads();
}
__device__ __forceinline__ void p_merge(const Frame& F, const bf16* OP, const float* ML, const bf16* OF, const float* gd, const float* gf, bf16* YN) {
    typedef float f32x2 __attribute__((ext_vector_type(2)));
    const int lane = F.lane; const bool dil = lane < 48; const int h = lane >> 2;
    v4u ro[6]; f32x2 rm[3];
#define MG_LOAD(t_) do { if (dil) { _Pragma("unroll") for (int br = 0; br < 3; ++br) { rm[br] = *(const GAS f32x2*)(ML + (((size_t)br * T + (t_)) * 12 + h) * 2); \
            const bf16* op_ = OP + ((size_t)br * T + (t_)) * 768 + lane * 16; ro[2 * br] = *(const GAS v4u*)op_; ro[2 * br + 1] = *(const GAS v4u*)(op_ + 8); } } \
        else { const bf16* op_ = OF + (size_t)(t_) * 256 + (lane - 48) * 16; ro[0] = *(const GAS v4u*)op_; ro[1] = *(const GAS v4u*)(op_ + 8); } } while (0)
    if (F.gw < T) MG_LOAD(F.gw);
    for (int t = F.gw; t < T; t += F.NGW) {
        asm volatile("" ::: "memory");
        float v[16];
        if (dil) {
            const float M = fmaxf(rm[0].x, fmaxf(rm[1].x, rm[2].x));
            float w[3], ws = 0.f;
#pragma unroll
            for (int br = 0; br < 3; ++br) { w[br] = rm[br].y * exp2f(rm[br].x - M); ws += w[br]; }
            const float iws = 1.f / ws;
#pragma unroll
            for (int j = 0; j < 16; ++j) v[j] = 0.f;
#pragma unroll
            for (int br = 0; br < 3; ++br) { float a[16]; unpack8(ro[2 * br], a); unpack8(ro[2 * br + 1], a + 8); const float wn = w[br] * iws;
#pragma unroll
                for (int j = 0; j < 16; ++j) v[j] += wn * a[j]; }
        } else { unpack8(ro[0], v); unpack8(ro[1], v + 8); }
        if (t + F.NGW < T) MG_LOAD(t + F.NGW);
        float ss = 0.f;
#pragma unroll
        for (int j = 0; j < 16; ++j) ss += v[j] * v[j];
        const float sd = wave_sum(dil ? ss : 0.f), sf = wave_sum(dil ? 0.f : ss);
        const float r = dil ? rsqrtf(sd / 768.f + RMS_EPS) : rsqrtf(sf / 256.f + RMS_EPS);
        float o[16];
        { const float* gp = dil ? gd + lane * 16 : gf + (lane - 48) * 16; asm volatile("" : "+v"(gp));
#pragma unroll
          for (int j4 = 0; j4 < 4; ++j4) { const f32x4 g4 = *(const GAS f32x4*)(gp + 4 * j4);
#pragma unroll
            for (int jj = 0; jj < 4; ++jj) o[4 * j4 + jj] = v[4 * j4 + jj] * r * g4[jj]; } }
        *(GAS v4u*)(YN + (size_t)t * D + lane * 16) = pack8(o); *(GAS v4u*)(YN + (size_t)t * D + lane * 16 + 8) = pack8(o + 8);
    }
#undef MG_LOAD
}
__device__ __forceinline__ void p_ln1(const Frame& F, const bf16* H0, const bf16* Y1, const float* g, const float* bb, const float* w_router, const float* b_router,
                                      bf16* H1, int* toke, float* tokg, int* histg, unsigned char* H1q) {
    typedef short bf16x8_t __attribute__((ext_vector_type(8))); typedef float f32x2_t __attribute__((ext_vector_type(2)));
    LAS unsigned char* wfr = F.lds; LAS int* hist = (LAS int*)(F.lds + 65536);
    LAS f32x2_t* part = (LAS f32x2_t*)(F.lds + 65536 + 256); LAS f32x4* racc = (LAS f32x4*)(F.lds + 65536 + 4096);
    for (int it = F.tid; it < 2048; it += 512) { const int s = it >> 6, l = it & 63; float w[8];
#pragma unroll
        for (int j = 0; j < 8; ++j) w[j] = w_router[(32 * s + 8 * (l >> 4) + j) * NE + (l & 15)];
        v4u hi4, lo4;
        hi4.x = pk2(w[0], w[1]); hi4.y = pk2(w[2], w[3]); hi4.z = pk2(w[4], w[5]); hi4.w = pk2(w[6], w[7]);
        lo4.x = pk2(w[0] - __uint_as_float(hi4.x << 16), w[1] - __uint_as_float(hi4.x & 0xffff0000u)); lo4.y = pk2(w[2] - __uint_as_float(hi4.y << 16), w[3] - __uint_as_float(hi4.y & 0xffff0000u));
        lo4.z = pk2(w[4] - __uint_as_float(hi4.z << 16), w[5] - __uint_as_float(hi4.z & 0xffff0000u)); lo4.w = pk2(w[6] - __uint_as_float(hi4.w << 16), w[7] - __uint_as_float(hi4.w & 0xffff0000u));
        *(LAS v4u*)(wfr + it * 32) = hi4; *(LAS v4u*)(wfr + it * 32 + 16) = lo4; }
    if (F.tid < NE) hist[F.tid] = 0;
    if (H1q && blockIdx.x == 0 && F.tid < 256) ((GAS unsigned*)(H1q + (size_t)T * D))[F.tid] = 0u;
    __syncthreads();
    const int lane = F.lane, tk = lane & 15, kq = lane >> 4, w8 = F.wave;
    const int col0 = 128 * w8 + 8 * kq;
    const float* gp = g + col0; const float* bp = bb + col0;
    v4u lh[4], ly[4];
#define LN1_LOAD(it_) do { const size_t ro_ = (size_t)(blockIdx.x * 128 + 16 * (it_) + tk) * D + col0; \
        _Pragma("unroll") for (int i = 0; i < 4; ++i) { lh[i] = *(const GAS v4u*)(H0 + ro_ + 32 * i); ly[i] = *(const GAS v4u*)(Y1 + ro_ + 32 * i); } } while (0)
    LN1_LOAD(0);
    for (int it = 0; it < 8; ++it) {
        asm volatile("" ::: "memory");
        const int t = blockIdx.x * 128 + 16 * it + tk;
        float u[32]; float sum = 0.f, sq = 0.f;
#pragma unroll
        for (int i = 0; i < 4; ++i) { float a[8], y[8]; unpack8(lh[i], a); unpack8(ly[i], y);
#pragma unroll
            for (int j = 0; j < 8; ++j) { const float x = ALPHA * a[j] + y[j]; u[8 * i + j] = x; sum += x; sq += x * x; } }
        if (it + 1 < 8) LN1_LOAD(it + 1);
        sum += __shfl_xor(sum, 16); sum += __shfl_xor(sum, 32); sq += __shfl_xor(sq, 16); sq += __shfl_xor(sq, 32);
        LAS f32x2_t* pp = part + (it & 1) * 128;
        if (lane < 16) pp[w8 * 16 + tk] = (f32x2_t){sum, sq};
        asm volatile("s_waitcnt lgkmcnt(0)\n\ts_barrier" ::: "memory");
        float ts = 0.f, tq = 0.f;
#pragma unroll
        for (int w = 0; w < 8; ++w) { const f32x2_t p = pp[w * 16 + tk]; ts += p.x; tq += p.y; }
        const float mu = ts * (1.f / D); const float rstd = rsqrtf(fmaxf(tq * (1.f / D) - mu * mu, 0.f) + LN_EPS);
        f32x4 acc = {0.f, 0.f, 0.f, 0.f};
#pragma unroll
        for (int i = 0; i < 4; ++i) {
            const f32x4 g0 = *(const GAS f32x4*)(gp + 32 * i), g1 = *(const GAS f32x4*)(gp + 32 * i + 4), b0 = *(const GAS f32x4*)(bp + 32 * i), b1 = *(const GAS f32x4*)(bp + 32 * i + 4);
            float v[8];
#pragma unroll
            for (int j = 0; j < 8; ++j) v[j] = (u[8 * i + j] - mu) * rstd * (j < 4 ? g0[j] : g1[j - 4]) + (j < 4 ? b0[j] : b1[j - 4]);
            v4u hi4, lo4;
            hi4.x = pk2(v[0], v[1]); hi4.y = pk2(v[2], v[3]); hi4.z = pk2(v[4], v[5]); hi4.w = pk2(v[6], v[7]);
            lo4.x = pk2(v[0] - __uint_as_float(hi4.x << 16), v[1] - __uint_as_float(hi4.x & 0xffff0000u)); lo4.y = pk2(v[2] - __uint_as_float(hi4.y << 16), v[3] - __uint_as_float(hi4.y & 0xffff0000u));
            lo4.z = pk2(v[4] - __uint_as_float(hi4.z << 16), v[5] - __uint_as_float(hi4.z & 0xffff0000u)); lo4.w = pk2(v[6] - __uint_as_float(hi4.w << 16), v[7] - __uint_as_float(hi4.w & 0xffff0000u));
            *(GAS v4u*)(H1 + (size_t)t * D + col0 + 32 * i) = hi4;
            if (H1q) { typedef unsigned u32x2_ __attribute__((ext_vector_type(2))); int w0 = 0, w1 = 0;
                w0 = __builtin_amdgcn_cvt_pk_fp8_f32(v[0], v[1], w0, false); w0 = __builtin_amdgcn_cvt_pk_fp8_f32(v[2], v[3], w0, true);
                w1 = __builtin_amdgcn_cvt_pk_fp8_f32(v[4], v[5], w1, false); w1 = __builtin_amdgcn_cvt_pk_fp8_f32(v[6], v[7], w1, true);
                *(GAS u32x2_*)(H1q + (size_t)t * D + col0 + 32 * i) = (u32x2_){(unsigned)w0, (unsigned)w1}; }
            const bf16x8_t ah = __builtin_bit_cast(bf16x8_t, hi4), al = __builtin_bit_cast(bf16x8_t, lo4);
            const int s = 4 * w8 + i;
            const bf16x8_t bh = *(const LAS bf16x8_t*)(wfr + (s * 64 + lane) * 32), bl = *(const LAS bf16x8_t*)(wfr + (s * 64 + lane) * 32 + 16);
            acc = __builtin_amdgcn_mfma_f32_16x16x32_bf16(ah, bh, acc, 0, 0, 0);
            acc = __builtin_amdgcn_mfma_f32_16x16x32_bf16(ah, bl, acc, 0, 0, 0);
            acc = __builtin_amdgcn_mfma_f32_16x16x32_bf16(al, bh, acc, 0, 0, 0); }
        racc[(it * 8 + w8) * 64 + lane] = acc;
    }
    __syncthreads();
    {
        const int it = w8;
        f32x4 lg = racc[(it * 8) * 64 + lane];
#pragma unroll
        for (int w = 1; w < 8; ++w) lg += racc[(it * 8 + w) * 64 + lane];
        const int e = lane & 15; const float bre = b_router[e];
#pragma unroll
        for (int r = 0; r < 4; ++r) {
            const int tt = blockIdx.x * 128 + 16 * it + 4 * kq + r;
            const float x = lg[r] + bre;
            float m = x; m = fmaxf(m, __shfl_xor(m, 1)); m = fmaxf(m, __shfl_xor(m, 2)); m = fmaxf(m, __shfl_xor(m, 4)); m = fmaxf(m, __shfl_xor(m, 8));
            float p = expf(x - m); float ss = p; ss += __shfl_xor(ss, 1); ss += __shfl_xor(ss, 2); ss += __shfl_xor(ss, 4); ss += __shfl_xor(ss, 8);
            p /= ss;
            const float o1 = __shfl_xor(p, 1), o2 = __shfl_xor(p, 2), o3 = __shfl_xor(p, 3);
            float gs = fmaxf(p + o1, fmaxf(p + o2, p + o3)); gs = fmaxf(gs, __shfl_xor(gs, 1)); gs = fmaxf(gs, __shfl_xor(gs, 2));
            float bv = gs; int bg = (lane >> 2) & 3;
#pragma unroll
            for (int off = 4; off <= 8; off <<= 1) { const float ov = __shfl_xor(bv, off); const int og = __shfl_xor(bg, off); if (ov > bv || (ov == bv && og < bg)) { bv = ov; bg = og; } }
            const int me = lane & 3;
            const int rank = ((o1 > p || (o1 == p && (me ^ 1) < me)) ? 1 : 0) + ((o2 > p || (o2 == p && (me ^ 2) < me)) ? 1 : 0) + ((o3 > p || (o3 == p && (me ^ 3) < me)) ? 1 : 0);
            float v12 = rank < 2 ? p : 0.f; v12 += __shfl_xor(v12, 1); v12 += __shfl_xor(v12, 2);
            if (((lane >> 2) & 3) == bg && rank < 2) { toke[tt * 2 + rank] = e; tokg[tt * 2 + rank] = p / v12; atomicAdd((int*)&hist[e], 1); }
        }
    }
#undef LN1_LOAD
    __syncthreads();
    { const int t2 = F.wave * 64 + fresh_lane(); if (t2 < NE) histg[blockIdx.x * NE + t2] = hist[t2]; }
    __syncthreads();
}
__device__ __forceinline__ void p_route(const Frame& F, const int* toke, int* rt, int* rowtok, int* slot) {
    LAS int* hs = (LAS int*)(F.lds);
    LAS int* part = hs + 256 * 17;
    LAS int* sh = part + 512;
    const int b = blockIdx.x, tid = F.tid, lane = F.lane;
    if (tid < 256) { const int* hp = rt + 16384 + tid * NE;
#pragma unroll
        for (int q = 0; q < 4; ++q) { const int4 c = *(const int4*)(hp + 4 * q); hs[tid * 17 + 4 * q] = c.x; hs[tid * 17 + 4 * q + 1] = c.y; hs[tid * 17 + 4 * q + 2] = c.z; hs[tid * 17 + 4 * q + 3] = c.w; } }
    const int my_e = tid < 256 ? (toke[b * 256 + tid] & (NE - 1)) : -1;
    __syncthreads();
    if (tid < 256) { const int e = tid & 15, p = tid >> 4; int tot = 0, pre = 0;
#pragma unroll
        for (int k = 0; k < 16; ++k) { const int blk = 16 * p + k; const int c = hs[blk * 17 + e]; tot += c; pre += blk < b ? c : 0; }
        part[e * 16 + p] = tot; part[256 + e * 16 + p] = pre; }
    int rank_w = 0;
    if (tid < 256) {
#pragma unroll
        for (int e = 0; e < NE; ++e) { const unsigned long long m = __ballot(my_e == e); if (my_e == e) rank_w = __popcll(m & ((1ull << lane) - 1ull)); if (lane == 0) sh[64 + F.wave * 16 + e] = __popcll(m); } }
    __syncthreads();
    if (tid < 16) { int tot = 0, pre = 0;
#pragma unroll
        for (int p = 0; p < 16; ++p) { tot += part[tid * 16 + p]; pre += part[256 + tid * 16 + p]; }
        sh[tid] = tot; sh[16 + tid] = pre; }
    __syncthreads();
    if (tid == 0) { int off = 0; for (int e = 0; e < NE; ++e) { sh[32 + e] = off; off += (sh[e] + RB - 1) / RB * RB; } sh[48] = off; }
    __syncthreads();
    if (tid < 256) { int r = rank_w; for (int w = 0; w < F.wave; ++w) r += sh[64 + w * 16 + my_e];
        const int pos = sh[32 + my_e] + sh[16 + my_e] + r; rowtok[pos] = b * 128 + (tid >> 1); slot[b * 256 + tid] = pos; }
    if (b < NE) { const int st = sh[32 + b] + sh[b], en = sh[32 + b] + (sh[b] + RB - 1) / RB * RB; for (int r = st + tid; r < en; r += 512) rowtok[r] = T; }
    if (b == 0) { if (tid == 0) rt[48] = sh[48];
        for (int e = 0; e < NE; ++e) { const int st = sh[32 + e] / RB, en = (sh[32 + e] + (sh[e] + RB - 1) / RB * RB) / RB; for (int r = st + tid; r < en; r += 512) rt[64 + r] = e; } }
    __syncthreads();
}
template <bool YB8>
__device__ __forceinline__ void p_ln2(const Frame& F, const bf16* H1, const bf16* YB, const int* slot, const float* tokg, const float* g, const float* bb, bf16* H0, float* outf,
                                      const float* w_in_next, const float* bf_next, float* logf) {
    const int lane = F.lane;
    LAS float* wfl = (LAS float*)F.lds;
    if (!outf) { for (int k = F.tid; k < D; k += 512) { const f32x4 w = *(const GAS f32x4*)(w_in_next + (size_t)k * NPROJ + NZ); wfl[k] = w.x; wfl[D + k] = w.y; wfl[2 * D + k] = w.z; wfl[3 * D + k] = w.w; }
        __syncthreads(); }
    const int nrow = (T - F.gw + F.NGW - 1) / F.NGW;
    int sl0 = 0, sl1 = 0; float gg0 = 0.f, gg1 = 0.f;
    if (lane < nrow) { const int tk = F.gw + lane * F.NGW; sl0 = slot[tk * 2]; sl1 = slot[tk * 2 + 1]; gg0 = tokg[tk * 2]; gg1 = tokg[tk * 2 + 1]; }
    v4u rh0, rh1, ra0, ra1, rb0, rb1;
#define LN2_LOAD(k_) do { const int tt_ = F.gw + (k_) * F.NGW; const int s0_ = __shfl(sl0, (k_)), s1_ = __shfl(sl1, (k_)); \
        const bf16* hp_ = H1 + (size_t)tt_ * D + lane * 16; rh0 = *(const GAS v4u*)hp_; rh1 = *(const GAS v4u*)(hp_ + 8); \
        if (YB8) { ra0 = *(const GAS v4u*)((const unsigned char*)YB + (size_t)s0_ * D + lane * 16); rb0 = *(const GAS v4u*)((const unsigned char*)YB + (size_t)s1_ * D + lane * 16); } \
        else { const bf16* p0_ = YB + (size_t)s0_ * D + lane * 16; const bf16* p1_ = YB + (size_t)s1_ * D + lane * 16; \
               ra0 = *(const GAS v4u*)p0_; ra1 = *(const GAS v4u*)(p0_ + 8); rb0 = *(const GAS v4u*)p1_; rb1 = *(const GAS v4u*)(p1_ + 8); } } while (0)
    if (nrow > 0) LN2_LOAD(0);
    for (int k = 0; k < nrow; ++k) {
        asm volatile("" ::: "memory");
        const int t = F.gw + k * F.NGW; const float g0 = __shfl(gg0, k), g1 = __shfl(gg1, k);
        float v[16]; float s = 0.f;
        { float a[16], y0[16], y1[16];
          unpack8(rh0, a); unpack8(rh1, a + 8);
          if (YB8) { typedef float f32x2_ __attribute__((ext_vector_type(2)));
#pragma unroll
              for (int q = 0; q < 4; ++q) { const int wa = (int)(q == 0 ? ra0.x : q == 1 ? ra0.y : q == 2 ? ra0.z : ra0.w), wb = (int)(q == 0 ? rb0.x : q == 1 ? rb0.y : q == 2 ? rb0.z : rb0.w);
                  const f32x2_ a0 = __builtin_amdgcn_cvt_pk_f32_fp8(wa, false), a1 = __builtin_amdgcn_cvt_pk_f32_fp8(wa, true), b0 = __builtin_amdgcn_cvt_pk_f32_fp8(wb, false), b1 = __builtin_amdgcn_cvt_pk_f32_fp8(wb, true);
                  y0[4 * q] = a0.x * 0.125f; y0[4 * q + 1] = a0.y * 0.125f; y0[4 * q + 2] = a1.x * 0.125f; y0[4 * q + 3] = a1.y * 0.125f;
                  y1[4 * q] = b0.x * 0.125f; y1[4 * q + 1] = b0.y * 0.125f; y1[4 * q + 2] = b1.x * 0.125f; y1[4 * q + 3] = b1.y * 0.125f; } }
          else { unpack8(ra0, y0); unpack8(ra1, y0 + 8); unpack8(rb0, y1); unpack8(rb1, y1 + 8); }
          if (k + 1 < nrow) LN2_LOAD(k + 1);
#pragma unroll
          for (int j = 0; j < 16; ++j) { v[j] = ALPHA * a[j] + (g0 * y0[j] + g1 * y1[j]); s += v[j]; } }
        const float mu = wave_sum(s) * (1.f / D); float q = 0.f;
#pragma unroll
        for (int j = 0; j < 16; ++j) { v[j] -= mu; q += v[j] * v[j]; }
        const float rstd = rsqrtf(wave_sum(q) * (1.f / D) + LN_EPS);
        { const float* gp = g + lane * 16; const float* bp = bb + lane * 16; asm volatile("" : "+v"(gp), "+v"(bp));
#pragma unroll
          for (int j4 = 0; j4 < 4; ++j4) { const f32x4 g4 = *(const GAS f32x4*)(gp + 4 * j4), b4 = *(const GAS f32x4*)(bp + 4 * j4);
#pragma unroll
            for (int jj = 0; jj < 4; ++jj) v[4 * j4 + jj] = v[4 * j4 + jj] * rstd * g4[jj] + b4[jj]; } }
        if (outf) { GAS f32x4* o = (GAS f32x4*)(outf + (size_t)t * D + lane * 16);
#pragma unroll
            for (int j = 0; j < 4; ++j) __builtin_nontemporal_store((f32x4){v[4 * j], v[4 * j + 1], v[4 * j + 2], v[4 * j + 3]}, (f32x4*)(o + j)); }
        else { *(GAS v4u*)(H0 + (size_t)t * D + lane * 16) = pack8(v); *(GAS v4u*)(H0 + (size_t)t * D + lane * 16 + 8) = pack8(v + 8);
            float acc[4] = {0.f, 0.f, 0.f, 0.f};
#pragma unroll
            for (int q = 0; q < 4; ++q)
#pragma unroll
                for (int j4 = 0; j4 < 4; ++j4) { const f32x4 w = *(const LAS f32x4*)(wfl + q * D + lane * 16 + 4 * j4); acc[q] += v[4 * j4] * w.x + v[4 * j4 + 1] * w.y + v[4 * j4 + 2] * w.z + v[4 * j4 + 3] * w.w; }
#pragma unroll
            for (int q = 0; q < 4; ++q) acc[q] = wave_sum(acc[q]);
            if (lane < 4) { const float z = (lane == 0 ? acc[0] : lane == 1 ? acc[1] : lane == 2 ? acc[2] : acc[3]) + bf_next[lane];
                logf[(size_t)t * 4 + lane] = fminf(z, 0.f) - log1pf(expf(-fabsf(z))); } }
    }
#undef LN2_LOAD
    __syncthreads();
}
#ifndef DUPMASK
#define DUPMASK 0u
#endif
template <int LITE = 0>
__device__ __forceinline__ void p_dil(const Frame& F, int vcu, const bf16* Z, bf16* OP, float* ML, int* dqc, const float* kmaxd) {
    char* shm = (char*)F.lds;
    att::u32x4 kv[12], qv[4]; att::bf16x8 qr[4];
    const int xcd_ = vcu >> 5;
    LAS int* dq = (LAS int*)(F.lds + att::L_WSF);
    const bool t0 = F.tid == 0;
    if (t0) { dq[0] = atomicAdd(dqc, 1); dq[1] = atomicAdd(dqc, 1); }
    __syncthreads();
    int ucur = dq[0], unxt = dq[1];
#define DIL_UNIT(q_) ((xcd_ + 8 * ((q_) / 48)) * 48 + (q_) % 48)
    att::DilU cu = att::dil_decode(DIL_UNIT(ucur < 576 ? ucur : 0)), nu = cu;
    if (ucur < 576) att::dil_issue(cu, Z, F.tid, kv, qv);
    for (int i = 0; ucur < 576; ++i) {
        att::dil_commit(shm, F.tid, kv, qv);
        if (unxt < 576) { nu = att::dil_decode(DIL_UNIT(unxt)); att::dil_issue(nu, Z, F.tid, kv, qv); }
        asm volatile("s_waitcnt lgkmcnt(0)\n\ts_barrier" ::: "memory");
        int ufut = 0; if (t0) ufut = atomicAdd(dqc, 1);
        att::dil_qfrag(shm, F.tid, qr);
        att::dil_compute<LITE>(cu, qr, OP, ML, shm, F.tid, kmaxd[cu.b * HD_DIL + cu.h]);
        if (t0) dq[2 + (i & 1)] = ufut;
        asm volatile("s_waitcnt lgkmcnt(0)\n\ts_barrier" ::: "memory");
        cu = nu; ucur = unxt; unxt = dq[2 + (i & 1)];
    }
#undef DIL_UNIT
}
__device__ __forceinline__ void p_fox(const Frame& F, int vcu, const bf16* Z, const float* logf, bf16* OF, const float* kmax) {
    char* shm = (char*)F.lds;
    const int bh = vcu >> 3, sidx = vcu & 7, b = bh >> 2, h = bh & 3;
    att::fox_bias(b, h, 256 * (16 - sidx), logf, shm, F.tid);
    const float bk2 = kmax[(b * HD_FOX + h) * 2] + kmax[(b * HD_FOX + h) * 2 + 1];
    att::fox_unit(b, h, 15 - sidx, Z, OF, shm, F.tid, bk2);
    att::fox_unit(b, h, sidx, Z, OF, shm, F.tid, bk2);
}

#ifndef GU_ALIGN
#define GU_ALIGN true
#endif
#ifndef IP_ALIGN
#define IP_ALIGN true
#endif
enum { PH_PRO = 0, PH_LOGF = 1, PH_INPROJ, PH_ATTN, PH_MERGE, PH_OUTPROJ, PH_LN1, PH_ROUTE, PH_GATEUP, PH_DOWN, PH_LN2, PH_PER_LAYER = 10, PH_TOTAL = 1 + 2 * PH_PER_LAYER };

__global__ void __launch_bounds__(NWAVES * 64, 2) mk_fwd(Args args) {
    extern __shared__ __attribute__((aligned(16))) unsigned char lds[];
    LAS unsigned char* const ldsb = (LAS unsigned char*)lds;
    typedef const __attribute__((address_space(4))) Args* KArgs;
    const int wave_s = __builtin_amdgcn_readfirstlane(threadIdx.x >> 6);
    const int bx = blockIdx.x; const int vcu = (gridDim.x % 8 == 0) ? (bx % 8) * ((int)gridDim.x / 8) + bx / 8 : bx;
#define MKF() KArgs ap = (KArgs)__builtin_amdgcn_kernarg_segment_ptr(); asm volatile("" : "+s"(ap)); Frame F; { F.lds = ldsb; F.lane = fresh_lane(); F.wave = wave_s; F.tid = wave_s * 64 + F.lane; \
                         F.G = gridDim.x; F.gw = vcu * NWAVES + F.wave; F.NGW = F.G * NWAVES; }
#define W_(off) (ap->ws + (off))
#define P_Z ((bf16*)W_(WS_Z))
#define P_OP ((bf16*)W_(WS_OP))
#define P_H0 ((bf16*)W_(WS_H0))
#define P_H1 ((bf16*)W_(WS_H1))
#define P_WINT ((bf16*)W_(WS_WIO))
#define P_WOUTT ((bf16*)W_(WS_WIO + 12 * MiB))
#define P_WGT ((bf16*)((unsigned char*)ap->out + OUT_WG))
#define P_WUT ((bf16*)((unsigned char*)ap->out + OUT_WU))
#define P_WDT ((bf16*)((unsigned char*)ap->out + OUT_WD))
#define P_WG8L(l_) ((unsigned char*)ap->out + (size_t)(l_) * OUT_WL + OUT_WG8)
#define P_WU8L(l_) ((unsigned char*)ap->out + (size_t)(l_) * OUT_WL + OUT_WU8)
#define P_WD8L(l_) ((unsigned char*)ap->out + (size_t)(l_) * OUT_WL + OUT_WD8)
#define P_WG8 P_WG8L(0)
#define P_WU8 P_WU8L(0)
#define P_WD8 P_WD8L(0)
#define P_H1Q ((unsigned char*)W_(WS_H1Q))
#define CONV_PULL(n_) conv_pull(F, ap->in[10] + (size_t)NE * D * D, ap->in[11] + (size_t)NE * D * D, ap->in[12] + (size_t)NE * D * D, P_WG8L(1), (int*)P_SM(SM_CTL) + CW_CQ, (n_))
#ifndef CQ_GU
#define CQ_GU 5
#endif
#ifndef CQ_DN
#define CQ_DN 5
#endif
#define CONV_EXPERTS(l_) do { const size_t eo_ = (size_t)(l_) * NE * D * D; \
        if (((l_) == 0) ? MOE_FP8_L0 : MOE_FP8_L1) { conv_expert_mat8(F, ap->in[10] + eo_, P_WG8); conv_expert_mat8(F, ap->in[11] + eo_, P_WU8); conv_expert_mat8(F, ap->in[12] + eo_, P_WD8); } \
        else { conv_expert_mat(F, ap->in[10] + eo_, P_WGT); conv_expert_mat(F, ap->in[11] + eo_, P_WUT); conv_expert_mat(F, ap->in[12] + eo_, P_WDT); } } while (0)
#define P_SM(off) (W_(WS_SM + (off)))
#define P_LOGF ((float*)P_SM(SM_LOGF))
#define P_TOKE ((int*)P_SM(SM_TOKE))
#define P_TOKG ((float*)P_SM(SM_TOKG))
#define P_SLOT ((int*)P_SM(SM_SLOT))
#define P_ROWTOK ((int*)P_SM(SM_ROWTOK))
#define P_RT ((int*)P_SM(SM_RT))
#define P_WF ((float*)P_SM(SM_WF))
#define P_ML ((float*)P_SM(SM_ML))
#define P_OF ((bf16*)P_SM(SM_OF))
    volatile LAS unsigned* MISC = (volatile LAS unsigned*)(ldsb + MISC_OFF);
    { const int l_ = fresh_lane(); if (wave_s == 0) MISC[l_] = 0u; }
    __syncthreads();
    unsigned* ctl; { KArgs ap = (KArgs)__builtin_amdgcn_kernarg_segment_ptr(); ctl = (unsigned*)P_SM(SM_CTL); }
    const bool multi = (args.ph_hi - args.ph_lo) > 1;
    XcdBarrier bar; bar.bar = ctl + CW_BAR; bar.x = 0; bar.st = nullptr;
#define T0_() (wave_s == 0 && fresh_lane() == 0)
    if (multi) bar = xcd_barrier_post(ctl + CW_BAR, MISC + 8, T0_());
    const int lo = args.ph_lo, hi = args.ph_hi;
#ifndef PHMASK
#define PHMASK 0xFFFFFFFFu
#endif
#define IN(k) (((PHMASK >> ((k) > 10 ? (k) - 10 : (k))) & 1u) && lo <= (k) && (k) < hi)
#define REP(k) for (int rep_ = 0; rep_ < (((DUPMASK >> (k)) & 1u) ? 2 : 1); ++rep_)
#define SEAM(k) do { if (IN(k) && IN((k) + 1)) { xcd_barrier(bar, T0_()); if ((DUPMASK >> 13) & 1u) xcd_barrier(bar, T0_()); } } while (0)
    if (IN(PH_PRO)) REP(PH_PRO) { MKF();
        p_prologue(F, ap->in[0], ap->in[1], ap->in[5], P_WINT, P_WOUTT, P_H0, P_H1, ap->in[2], P_LOGF);
        CONV_EXPERTS(0);
    } SEAM(PH_PRO);
    auto layer = [&](auto lc) __attribute__((always_inline)) {
        constexpr int l = decltype(lc)::value; constexpr int base = l * PH_PER_LAYER; constexpr bool F8 = (l == 0) ? MOE_FP8_L0 : MOE_FP8_L1;
        if (IN(base + PH_INPROJ)) REP(PH_INPROJ) { MKF();
            pg8::Gemm g{P_H0, P_WINT + (size_t)l * NZ * D, nullptr, nullptr};
            pg8::TileOrder So; So.init(T / 256, NZ / 256, F.G, bx);
            pg8::EpiInproj E{P_Z, (unsigned*)P_SM(SM_CTL) + CW_KMAX + l * 64, (unsigned*)P_SM(SM_CTL) + CW_KMAXD + l * 96};
            pg8::gemm_phase<pg8::EpiInproj, 128L * D * 2, 256, false, false, false, IP_ALIGN>(F.lds, g, So, E, F.tid);
        } SEAM(base + PH_INPROJ);
        if (IN(base + PH_ATTN)) {
            if ((DUPMASK >> 20) & 1u) { MKF(); p_fox(F, vcu, P_Z, P_LOGF, P_OF, (const float*)((unsigned*)P_SM(SM_CTL) + CW_KMAX + l * 64)); __syncthreads(); asm volatile("" ::: "memory"); }
            { MKF(); p_fox(F, vcu, P_Z, P_LOGF, P_OF, (const float*)((unsigned*)P_SM(SM_CTL) + CW_KMAX + l * 64)); }
            asm volatile("" ::: "memory");
            if ((DUPMASK >> 27) & 1u) { MKF(); p_dil<1>(F, vcu, P_Z, P_OP, P_ML, (int*)P_SM(SM_CTL) + CW_DQ + 2048 + (l * 8 + (vcu >> 5)) * 64, (const float*)((unsigned*)P_SM(SM_CTL) + CW_KMAXD + l * 96)); __syncthreads(); asm volatile("" ::: "memory"); }
            if ((DUPMASK >> 26) & 1u) { MKF(); p_dil(F, vcu, P_Z, P_OP, P_ML, (int*)P_SM(SM_CTL) + CW_DQ + 2048 + (l * 8 + (vcu >> 5)) * 64, (const float*)((unsigned*)P_SM(SM_CTL) + CW_KMAXD + l * 96)); __syncthreads(); asm volatile("" ::: "memory"); }
            { MKF(); p_dil(F, vcu, P_Z, P_OP, P_ML, (int*)P_SM(SM_CTL) + CW_DQ + (l * 8 + (vcu >> 5)) * 64, (const float*)((unsigned*)P_SM(SM_CTL) + CW_KMAXD + l * 96)); } } SEAM(base + PH_ATTN);
        if (IN(base + PH_MERGE)) REP(PH_MERGE) { MKF(); p_merge(F, P_OP, P_ML, P_OF, ap->in[3] + l * 768, ap->in[4] + l * 256, P_H1  ); } SEAM(base + PH_MERGE);
        if (IN(base + PH_OUTPROJ)) REP(PH_OUTPROJ) { MKF();
            pg8::Gemm g{P_H1  , P_WOUTT + (size_t)l * D * D, nullptr, nullptr};
            pg8::TileOrder So; So.init(T / 256, D / 256, F.G, bx);
            pg8::EpiPlain E{P_Z  , D, 1.f};
            pg8::gemm_phase<pg8::EpiPlain, 128L * D * 2, 256, false, false>(F.lds, g, So, E, F.tid);
        } SEAM(base + PH_OUTPROJ);
        if (IN(base + PH_LN1)) REP(PH_LN1) { MKF(); p_ln1(F, P_H0, P_Z  , ap->in[6] + l * D, ap->in[7] + l * D, ap->in[8], ap->in[9], P_H1, P_TOKE, P_TOKG, P_RT + 16384, F8 ? P_H1Q : nullptr); } SEAM(base + PH_LN1);
        if (IN(base + PH_ROUTE)) REP(PH_ROUTE) { MKF(); p_route(F, P_TOKE, P_RT, P_ROWTOK, P_SLOT); } SEAM(base + PH_ROUTE);
        if (IN(base + PH_GATEUP)) REP(PH_GATEUP) { MKF();
            const int nblk = __builtin_amdgcn_readfirstlane(P_RT[48]) / RB;
            pg8::TileOrder So; So.init(nblk, 8, F.G, bx);
            if constexpr (F8) { pg8::Gemm g{P_H1Q, P_WG8L(l), P_ROWTOK, P_RT + 64}; pg8::EpiSwiglu8 E{(unsigned char*)P_Z  };
                pg8::gemm_phase<pg8::EpiSwiglu8, (long)(OUT_WU8 - OUT_WG8), 128, true, true, true, GU_ALIGN>(F.lds, g, So, E, F.tid);
                if constexpr (l == 0 && MOE_FP8_L1) { asm volatile("" ::: "memory"); const int nwg = (__builtin_amdgcn_readfirstlane(P_RT[48]) / RB) * 8, mine = nwg > bx ? (nwg - bx + F.G - 1) / F.G : 0, mx = (nwg + F.G - 1) / F.G;
                    if (mx > mine) CONV_PULL((mx - mine) * CQ_GU); } }
            else { pg8::Gemm g{P_H1, P_WGT, P_ROWTOK, P_RT + 64}; pg8::EpiSwiglu E{P_Z  };
                pg8::gemm_phase<pg8::EpiSwiglu, (long)(OUT_WU - OUT_WG), 128, true, true>(F.lds, g, So, E, F.tid); }
        } SEAM(base + PH_GATEUP);
        if (IN(base + PH_DOWN)) REP(PH_DOWN) { MKF();
            const int nblk = __builtin_amdgcn_readfirstlane(P_RT[48]) / RB;
            pg8::TileOrder So; So.init(nblk, 4, F.G, bx);
            if constexpr (F8) { pg8::Gemm g{P_Z  , P_WD8L(l), nullptr, P_RT + 64}; pg8::EpiPlain8 E{(unsigned char*)P_OP  , 8.f / 32.f};
                pg8::gemm_phase<pg8::EpiPlain8, 128L * D, 256, false, true, true>(F.lds, g, So, E, F.tid);
                if constexpr (l == 0 && MOE_FP8_L1) { asm volatile("" ::: "memory"); const int nwg = (__builtin_amdgcn_readfirstlane(P_RT[48]) / RB) * 4, mine = nwg > bx ? (nwg - bx + F.G - 1) / F.G : 0, mx = (nwg + F.G - 1) / F.G;
                    if (mx > mine) CONV_PULL((mx - mine) * CQ_DN); } }
            else { pg8::Gemm g{P_Z  , P_WDT, nullptr, P_RT + 64}; pg8::EpiPlain E{P_OP  , D, 1.f};
                pg8::gemm_phase<pg8::EpiPlain, 128L * D * 2, 256, false, true>(F.lds, g, So, E, F.tid); }
        } SEAM(base + PH_DOWN);
        if (IN(base + PH_LN2)) REP(PH_LN2) { MKF();
            p_ln2<F8>(F, P_H1, P_OP  , P_SLOT, P_TOKG, ap->in[13] + l * D, ap->in[14] + l * D, P_H0, l == DEPTH - 1 ? ap->out : nullptr,
                  ap->in[1] + (size_t)(l + 1 < DEPTH ? l + 1 : 0) * D * NPROJ, ap->in[2] + (l + 1 < DEPTH ? l + 1 : 0) * 4, P_LOGF);
            if constexpr (l + 1 < DEPTH) { if constexpr (MOE_FP8_L1) CONV_PULL(0x7fffffff); else CONV_EXPERTS(l + 1); }
        } SEAM(base + PH_LN2);
    };
    layer(std::integral_constant<int, 0>{});
    layer(std::integral_constant<int, 1>{});
    if (lo == 100) { MKF(); CONV_PULL(0x7fffffff); }
#undef IN
#undef SEAM
}


extern "C" void kernel_launch(void* const* d_in, const int* in_sizes, int n_in, void* d_out, int out_size, void* d_ws, size_t ws_size, hipStream_t stream) {
    static int grid = 0;
    if (grid == 0) {
        if (n_in != 15 || out_size != T * D || ws_size < WS_END) { fprintf(stderr, "kernel_launch: unexpected shapes / workspace (%d inputs, out %d, ws %zu < %zu)\n", n_in, out_size, ws_size, (size_t)WS_END); grid = -1; return; }
        int dev = 0, cus = 0;
        if (hipGetDevice(&dev) != hipSuccess || hipDeviceGetAttribute(&cus, hipDeviceAttributeMultiprocessorCount, dev) != hipSuccess) { grid = -1; return; }
        if (hipFuncSetAttribute((const void*)mk_fwd, hipFuncAttributeMaxDynamicSharedMemorySize, LDS_BYTES) != hipSuccess) { grid = -1; return; }
        int per_cu = 0; (void)hipOccupancyMaxActiveBlocksPerMultiprocessor(&per_cu, (const void*)mk_fwd, NWAVES * 64, LDS_BYTES); (void)hipGetLastError();
        if (cus != 256 || per_cu < 1) { fprintf(stderr, "kernel_launch: needs 256 CUs with one resident workgroup each (cus %d, per_cu %d)\n", cus, per_cu); grid = -1; return; }
        grid = 256;
    }
    if (grid < 0) return;
    unsigned char* sm = (unsigned char*)d_ws + WS_SM;
    (void)hipMemsetAsync(sm + SM_CTL, 0, 1 * MiB, stream);
    Args a{};
    for (int i = 0; i < 15; ++i) a.in[i] = (const float*)d_in[i];
    a.out = (float*)d_out; a.ws = (unsigned char*)d_ws;
#if MK_DEBUG
    debug_forward(a, d_in, d_out, d_ws, stream, grid);
#else
    a.ph_lo = 0; a.ph_hi = PH_TOTAL; a.li = 0;
    hipLaunchKernelGGL(mk_fwd, dim3(grid), dim3(NWAVES * 64), LDS_BYTES, stream, a);
#endif
}
```

```cpp
#include <hip/hip_runtime.h>
#include <stdint.h>
#include <math.h>
#include <cstdio>

#ifndef MK_DEBUG
#define MK_DEBUG 0
#endif
#ifndef NAIVE_MASK
#define NAIVE_MASK 0
#endif

typedef unsigned short bf16;
constexpr int NB = 8, S = 4096, D = 1024, T = NB * S, DEPTH = 2;
constexpr int NPROJ = 3076, NZ = 3072;
constexpr int HD_DIL = 12, HD_FOX = 4;
constexpr int NE = 16;
constexpr int RB = 256;
constexpr int ROWS_MAX = 2 * T + NE * RB;
constexpr int NBLK_MAX = ROWS_MAX / RB;
constexpr float ALPHA = 1.41421356237f;
constexpr float LN_EPS = 1e-5f, RMS_EPS = 1e-6f;
constexpr float LOG2E = 1.4426950408889634f;
constexpr float C2 = 0.125f * LOG2E;
constexpr size_t RQA = 0, RKA = (size_t)T * 768, RVA = (size_t)T * 1536, RQF = (size_t)T * 2304, RKF = (size_t)T * 2560, RVF = (size_t)T * 2816;

__device__ __forceinline__ float bf2f(bf16 v) { return __uint_as_float(((unsigned)v) << 16); }
__device__ __forceinline__ bf16 f2bf(float f) { unsigned u = __float_as_uint(f); return (bf16)((u + 0x7fffu + ((u >> 16) & 1u)) >> 16); }
typedef float f32x2_cv __attribute__((ext_vector_type(2))); typedef __bf16 bf16x2_cv __attribute__((ext_vector_type(2)));
__device__ __forceinline__ unsigned pk2(float lo, float hi) { f32x2_cv v = {lo, hi}; bf16x2_cv b = __builtin_convertvector(v, bf16x2_cv); return __builtin_bit_cast(unsigned, b); }

constexpr size_t MiB = 1u << 20;
constexpr size_t WS_Z = 0;
constexpr size_t WS_OP = 192 * MiB;
constexpr size_t WS_H0 = 336 * MiB;
constexpr size_t WS_H1 = 401 * MiB;
constexpr size_t WS_WIO = 466 * MiB;
constexpr size_t WS_SM = 482 * MiB;
constexpr size_t SM_CTL = 0;
constexpr size_t SM_LOGF = 1 * MiB;
constexpr size_t SM_CUM = 2 * MiB;
constexpr size_t SM_TOKE = 3 * MiB;
constexpr size_t SM_TOKG = 4 * MiB;
constexpr size_t SM_SLOT = 5 * MiB;
constexpr size_t SM_ROWTOK = 6 * MiB;
constexpr size_t SM_RT = 7 * MiB;
constexpr size_t SM_WF = 8 * MiB;
constexpr size_t SM_ML = 9 * MiB;
constexpr size_t SM_OF = 18 * MiB;
constexpr size_t WS_END = WS_SM + 34 * MiB;
constexpr size_t OUT_WG = 0, OUT_WU = 32 * MiB, OUT_WD = 64 * MiB;
constexpr size_t OUT_WG8 = 0, OUT_WU8 = 16 * MiB, OUT_WD8 = 32 * MiB, OUT_WL = 48 * MiB;
constexpr size_t WS_H1Q = WS_Z + 128 * MiB;
#ifndef MOE_FP8_L0
#define MOE_FP8_L0 1
#endif
#ifndef MOE_FP8_L1
#define MOE_FP8_L1 1
#endif
constexpr int CW_BAR = 4096;
constexpr int CW_CQ = 20480;
constexpr int CW_DQ = 16384;
constexpr int CW_KMAXD = 8320;
constexpr int CW_KMAX = 8192;

namespace pg8 {
#define PG8_LAS __attribute__((address_space(3)))
typedef unsigned short bf16_t;
typedef short bf16x8 __attribute__((ext_vector_type(8)));
typedef float f32x4 __attribute__((ext_vector_type(4)));
typedef unsigned u32x4 __attribute__((ext_vector_type(4)));
constexpr int BM = 256, BK = 64, HALF = 128, HTB = HALF * BK * 2, STAGE_BYTES = 8 * HTB, NXCD = 8, WGM = 8;
constexpr int GT_MAX = 10;
constexpr int GTAB_OFF = STAGE_BYTES;
constexpr int ETAB_OFF = GTAB_OFF + GT_MAX * 1024;

__host__ __device__ __forceinline__ int lds_byte(int r, int c) { const int st = (r >> 4) * 2 + (c >> 5), rr = r & 15, cc = c & 31, ob = rr * 64 + cc * 2; return st * 1024 + (ob ^ (((ob >> 9) & 1) << 5)); }
__host__ __device__ __forceinline__ void stage_rc(int b, int& R, int& C) { const int st = b / 1024, sb = b % 1024, swz = sb ^ (((sb >> 9) & 1) << 5); R = (st >> 1) * 16 + swz / 64; C = (st & 1) * 32 + (swz % 64) / 2; }
__host__ __device__ __forceinline__ int perm32(int rho) { const int n = rho >> 4, i = rho & 15; return 8 * (i >> 2) + 4 * n + (i & 3); }

struct Unit { int pm, pn; };
struct TileOrder {
    int nM, nN, nwg, G, c;
    __device__ void init(int nM_, int nN_, int G_, int c_) { nM = nM_; nN = nN_; nwg = nM * nN; G = G_; c = c_; }
    __device__ bool next(int i, Unit& u) const {
        const long L = (long)i * G + c; if (L >= nwg) return false;
        int wgid = (int)L; { const int q = nwg / NXCD, r = nwg % NXCD, xcd = wgid % NXCD, off = wgid / NXCD; wgid = (xcd < r ? xcd * (q + 1) : r * (q + 1) + (xcd - r) * q) + off; }
        const int nig = WGM * nN, gid = wgid / nig, fm = gid * WGM, gsz = (nM - fm) < WGM ? (nM - fm) : WGM;
        u.pm = fm + ((wgid % nig) % gsz); u.pn = (wgid % nig) / gsz; return true;
    }
};
struct Gemm { const void* A; const void* B0; const int* gather; const int* blk_e; };

__device__ __forceinline__ unsigned cvt_pk_bf16(float lo, float hi) { unsigned r; asm volatile("v_cvt_pk_bf16_f32 %0, %1, %2" : "=v"(r) : "v"(lo), "v"(hi)); return r; }

#ifndef WT_STORES
#define WT_STORES 0
#endif
__device__ __forceinline__ void st16(void* p, u32x4 v) {
#if WT_STORES
    asm volatile("global_store_dwordx4 %0, %1, off sc1\n\ts_nop 1" :: "v"(p), "v"(v) : "memory");
#else
    *(u32x4*)p = v;
#endif
}
typedef unsigned u32x2_st __attribute__((ext_vector_type(2)));
__device__ __forceinline__ void st8(void* p, u32x2_st v) {
#if WT_STORES
    asm volatile("global_store_dwordx2 %0, %1, off sc1\n\ts_nop 1" :: "v"(p), "v"(v) : "memory");
#else
    *(u32x2_st*)p = v;
#endif
}
struct EpiPlain {
    bf16_t* O; int ldc; float sc;
    __device__ __forceinline__ void operator()(const f32x4 (&acc)[2][2][4][2], const Unit& u, int wr, int wc, int fr, int fq) const {
        const int row0 = u.pm * BM + wr * 64 + fr; const int col0 = u.pn * BM + wc * 32 + 8 * fq;
#pragma unroll
        for (int ai = 0; ai < 2; ++ai)
#pragma unroll
            for (int m = 0; m < 4; ++m) { bf16_t* rowp = O + (size_t)(row0 + ai * HALF + m * 16) * ldc + col0;
#pragma unroll
                for (int bj = 0; bj < 2; ++bj) { const f32x4 v0 = acc[ai][bj][m][0], v1 = acc[ai][bj][m][1];
                    u32x4 w; w.x = cvt_pk_bf16(v0[0], v0[1]); w.y = cvt_pk_bf16(v0[2], v0[3]); w.z = cvt_pk_bf16(v1[0], v1[1]); w.w = cvt_pk_bf16(v1[2], v1[3]);
                    st16(rowp + bj * HALF, w); } }
    }
};
struct EpiPlain8 {
    unsigned char* O; float sc;
    __device__ __forceinline__ void operator()(const f32x4 (&acc)[2][2][4][2], const Unit& u, int wr, int wc, int fr, int fq) const {
        const int row0 = u.pm * BM + wr * 64 + fr; const int col0 = u.pn * BM + wc * 32 + 8 * fq;
#pragma unroll
        for (int ai = 0; ai < 2; ++ai)
#pragma unroll
            for (int m = 0; m < 4; ++m) { unsigned char* rowp = O + (size_t)(row0 + ai * HALF + m * 16) * 1024 + col0;
#pragma unroll
                for (int bj = 0; bj < 2; ++bj) { const f32x4 v0 = acc[ai][bj][m][0] * sc, v1 = acc[ai][bj][m][1] * sc;
                    int w0 = 0, w1 = 0;
                    w0 = __builtin_amdgcn_cvt_pk_fp8_f32(v0[0], v0[1], w0, false); w0 = __builtin_amdgcn_cvt_pk_fp8_f32(v0[2], v0[3], w0, true);
                    w1 = __builtin_amdgcn_cvt_pk_fp8_f32(v1[0], v1[1], w1, false); w1 = __builtin_amdgcn_cvt_pk_fp8_f32(v1[2], v1[3], w1, true);
                    st8(rowp + bj * HALF, (u32x2_st){(unsigned)w0, (unsigned)w1}); } }
    }
};
struct EpiSwiglu {
    bf16_t* O;
    __device__ __forceinline__ void operator()(const f32x4 (&acc)[2][2][4][2], const Unit& u, int wr, int wc, int fr, int fq) const {
        const int row0 = u.pm * BM + wr * 64 + fr; const int col0 = u.pn * HALF + wc * 32 + 8 * fq;
#pragma unroll
        for (int ai = 0; ai < 2; ++ai)
#pragma unroll
            for (int m = 0; m < 4; ++m) { bf16_t* rowp = O + (size_t)(row0 + ai * HALF + m * 16) * 1024 + col0;
                float r[8];
#pragma unroll
                for (int n = 0; n < 2; ++n)
#pragma unroll
                    for (int j = 0; j < 4; ++j) { const float g = acc[ai][0][m][n][j], up = acc[ai][1][m][n][j];
                        r[n * 4 + j] = g * __builtin_amdgcn_rcpf(1.f + __builtin_amdgcn_exp2f(-g * LOG2E)) * up; }
                u32x4 w; w.x = cvt_pk_bf16(r[0], r[1]); w.y = cvt_pk_bf16(r[2], r[3]); w.z = cvt_pk_bf16(r[4], r[5]); w.w = cvt_pk_bf16(r[6], r[7]);
                st16(rowp, w); __builtin_amdgcn_sched_barrier(0); }
    }
};
struct EpiSwiglu8 {
    unsigned char* O;
    __device__ __forceinline__ void operator()(const f32x4 (&acc)[2][2][4][2], const Unit& u, int wr, int wc, int fr, int fq) const {
        typedef unsigned u32x2 __attribute__((ext_vector_type(2)));
        const int row0 = u.pm * BM + wr * 64 + fr; const int col0 = u.pn * HALF + wc * 32 + 8 * fq;
#pragma unroll
        for (int ai = 0; ai < 2; ++ai)
#pragma unroll
            for (int m = 0; m < 4; ++m) { unsigned char* rowp = O + (size_t)(row0 + ai * HALF + m * 16) * 1024 + col0;
                float r[8];
#pragma unroll
                for (int n = 0; n < 2; ++n)
#pragma unroll
                    for (int jp = 0; jp < 2; ++jp) { typedef float f32x2_ __attribute__((ext_vector_type(2)));
                        const f32x2_ g2 = {acc[ai][0][m][n][2 * jp], acc[ai][0][m][n][2 * jp + 1]}, u2 = {acc[ai][1][m][n][2 * jp], acc[ai][1][m][n][2 * jp + 1]};
                        const f32x2_ x2 = g2 * (-LOG2E / 32.f);
                        const f32x2_ e2 = {__builtin_amdgcn_exp2f(x2.x), __builtin_amdgcn_exp2f(x2.y)};
                        const f32x2_ d2 = e2 * 1024.f + 1024.f;
                        const f32x2_ q2 = {__builtin_amdgcn_rcpf(d2.x), __builtin_amdgcn_rcpf(d2.y)};
                        const f32x2_ o2 = (g2 * u2) * q2;
                        r[n * 4 + 2 * jp] = o2.x; r[n * 4 + 2 * jp + 1] = o2.y; }
                int w0 = 0, w1 = 0;
                w0 = __builtin_amdgcn_cvt_pk_fp8_f32(r[0], r[1], w0, false); w0 = __builtin_amdgcn_cvt_pk_fp8_f32(r[2], r[3], w0, true);
                w1 = __builtin_amdgcn_cvt_pk_fp8_f32(r[4], r[5], w1, false); w1 = __builtin_amdgcn_cvt_pk_fp8_f32(r[6], r[7], w1, true);
                st8(rowp, (u32x2_st){(unsigned)w0, (unsigned)w1}); __builtin_amdgcn_sched_barrier(0); }
    }
};
struct EpiInproj {
    bf16_t* Z; unsigned* kmax; unsigned* kmaxd;
    __device__ __forceinline__ void operator()(const f32x4 (&acc)[2][2][4][2], const Unit& u, int wr, int wc, int fr, int fq) const {
        const int row0 = u.pm * BM + wr * 64 + fr;
        const int bb = (u.pm * BM) / S;
        if (u.pn < 6) {
            typedef float f32x2_ __attribute__((ext_vector_type(2)));
            f32x2_ ir2[4], cd2[4], sd2[4];
#pragma unroll
            for (int p = 0; p < 4; ++p) {
                ir2[p] = (f32x2_){__builtin_amdgcn_exp2f(-(float)(8 * fq + 2 * p) * (13.287712379549449f / 32.f)) * 0.15915494309189535f, __builtin_amdgcn_exp2f(-(float)(8 * fq + 2 * p + 1) * (13.287712379549449f / 32.f)) * 0.15915494309189535f};
                const f32x2_ r16 = ir2[p] * 16.f;
                cd2[p] = (f32x2_){__builtin_amdgcn_cosf(__builtin_amdgcn_fractf(r16.x)), __builtin_amdgcn_cosf(__builtin_amdgcn_fractf(r16.y))};
                sd2[p] = (f32x2_){__builtin_amdgcn_sinf(__builtin_amdgcn_fractf(r16.x)), __builtin_amdgcn_sinf(__builtin_amdgcn_fractf(r16.y))}; }
            const int head = 4 * (u.pn % 3) + wc;
            bf16_t* base = Z + (u.pn < 3 ? RQA : RKA) + ((size_t)(bb * HD_DIL + head) * S) * 64 + 8 * fq;
            float knrm = 0.f;
#pragma unroll
            for (int ai = 0; ai < 2; ++ai) {
                f32x2_ c2[4], s2[4];
                { const float pos0 = (float)((row0 + ai * HALF) & (S - 1));
#pragma unroll
                  for (int p = 0; p < 4; ++p) { const f32x2_ rv = ir2[p] * pos0; const float r0 = __builtin_amdgcn_fractf(rv.x), r1 = __builtin_amdgcn_fractf(rv.y);
                      c2[p] = (f32x2_){__builtin_amdgcn_cosf(r0), __builtin_amdgcn_cosf(r1)}; s2[p] = (f32x2_){__builtin_amdgcn_sinf(r0), __builtin_amdgcn_sinf(r1)}; } }
#pragma unroll
                for (int m = 0; m < 4; ++m) { const int row = row0 + ai * HALF + m * 16; const int spos = row & (S - 1);
                    if (m > 0) {
#pragma unroll
                        for (int p = 0; p < 4; ++p) { const f32x2_ cn = c2[p] * cd2[p] - s2[p] * sd2[p]; s2[p] = s2[p] * cd2[p] + c2[p] * sd2[p]; c2[p] = cn; } }
                    float o1[8], o2[8];
#pragma unroll
                    for (int p = 0; p < 4; ++p) { const int n = p >> 1, j = 2 * (p & 1);
                        const f32x2_ t1 = {acc[ai][0][m][n][j], acc[ai][0][m][n][j + 1]}, t2 = {acc[ai][1][m][n][j], acc[ai][1][m][n][j + 1]};
                        const f32x2_ a1 = t1 * c2[p] - t2 * s2[p], a2 = t2 * c2[p] + t1 * s2[p];
                        o1[2 * p] = a1.x; o1[2 * p + 1] = a1.y; o2[2 * p] = a2.x; o2[2 * p + 1] = a2.y; }
                    bf16_t* rowp = base + (size_t)spos * 64;
                    u32x4 w; w.x = cvt_pk_bf16(o1[0], o1[1]); w.y = cvt_pk_bf16(o1[2], o1[3]); w.z = cvt_pk_bf16(o1[4], o1[5]); w.w = cvt_pk_bf16(o1[6], o1[7]);
                    st16(rowp, w);
                    w.x = cvt_pk_bf16(o2[0], o2[1]); w.y = cvt_pk_bf16(o2[2], o2[3]); w.z = cvt_pk_bf16(o2[4], o2[5]); w.w = cvt_pk_bf16(o2[6], o2[7]);
                    st16(rowp + 32, w);
                    if (u.pn >= 3) { float p = 0.f;
#pragma unroll
                        for (int k = 0; k < 8; ++k) p += o1[k] * o1[k] + o2[k] * o2[k];
                        p += __shfl_xor(p, 16); p += __shfl_xor(p, 32); knrm = fmaxf(knrm, p); }
                    __builtin_amdgcn_sched_barrier(0); } }
            if (u.pn >= 3) { knrm = fmaxf(knrm, __shfl_xor(knrm, 1)); knrm = fmaxf(knrm, __shfl_xor(knrm, 2)); knrm = fmaxf(knrm, __shfl_xor(knrm, 4)); knrm = fmaxf(knrm, __shfl_xor(knrm, 8));
                if (fr == 0 && fq == 0) atomicMax(kmaxd + bb * HD_DIL + head, __float_as_uint(knrm)); }
        } else {
            const bool fox = u.pn >= 9; const int nh = fox ? HD_FOX : HD_DIL;
            const size_t reg = u.pn < 9 ? RVA : (u.pn == 9 ? RQF : (u.pn == 10 ? RKF : RVF));
            const int head0 = (fox ? 0 : 4 * (u.pn - 6)) + (wc >> 1);
            bf16_t* base = Z + reg + 32 * (wc & 1) + 8 * fq;
#pragma unroll
            for (int ai = 0; ai < 2; ++ai)
#pragma unroll
                for (int m = 0; m < 4; ++m) { const int spos = (row0 + ai * HALF + m * 16) & (S - 1);
#pragma unroll
                    for (int bj = 0; bj < 2; ++bj) { const f32x4 v0 = acc[ai][bj][m][0], v1 = acc[ai][bj][m][1];
                        u32x4 w; w.x = cvt_pk_bf16(v0[0], v0[1]); w.y = cvt_pk_bf16(v0[2], v0[3]); w.z = cvt_pk_bf16(v1[0], v1[1]); w.w = cvt_pk_bf16(v1[2], v1[3]);
                        st16(base + ((size_t)(bb * nh + head0 + 2 * bj) * S + spos) * 64, w); } }
#ifndef FOX_NOKMAX
            if (u.pn == 10) {
#pragma unroll
                for (int bj = 0; bj < 2; ++bj) { float mxp = 0.f;
#pragma unroll
                    for (int ai = 0; ai < 2; ++ai)
#pragma unroll
                        for (int m = 0; m < 4; ++m) { const f32x4 a0 = acc[ai][bj][m][0], a1 = acc[ai][bj][m][1];
                            float p = (a0[0] * a0[0] + a0[1] * a0[1]) + (a0[2] * a0[2] + a0[3] * a0[3]) + (a1[0] * a1[0] + a1[1] * a1[1]) + (a1[2] * a1[2] + a1[3] * a1[3]);
                            p += __shfl_xor(p, 16); p += __shfl_xor(p, 32); mxp = fmaxf(mxp, p); }
                    mxp = fmaxf(mxp, __shfl_xor(mxp, 1)); mxp = fmaxf(mxp, __shfl_xor(mxp, 2)); mxp = fmaxf(mxp, __shfl_xor(mxp, 4)); mxp = fmaxf(mxp, __shfl_xor(mxp, 8));
                    if (fr == 0 && fq == 0) atomicMax(kmax + ((bb * HD_FOX + head0 + 2 * bj) * 2 + (wc & 1)), __float_as_uint(mxp)); }
            }
#endif
        }
    }
};

template <class Epi, long BHSTEP  , int BN_ROWS, bool GATHER, bool GROUPED, bool FP8 = false, bool ALIGN = true>
__device__ __forceinline__ void gemm_phase(PG8_LAS unsigned char* lds, const Gemm g, const TileOrder& S, const Epi& E, const int tid) {
    const int wid = __builtin_amdgcn_readfirstlane(tid >> 6), lane = tid & 63, wr = wid >> 2, wc = wid & 3, fr = lane & 15, fq = lane >> 4;
    constexpr int K = 1024, KB = FP8 ? K : 2 * K  , nt = KB / (BK * 2)  ; constexpr long ESTRIDE = (long)K * KB;
    PG8_LAS int* gtab = (PG8_LAS int*)(lds + GTAB_OFF); PG8_LAS int* etab = (PG8_LAS int*)(lds + ETAB_OFF);
    unsigned voffB[2];
#pragma unroll
    for (int i = 0; i < 2; ++i) { int R, C; stage_rc(tid * 16 + i * 8192, R, C); const int Rb = (R & ~31) + perm32(R & 31); voffB[i] = (unsigned)(Rb * KB + C * 2); }
    if (GATHER || GROUPED) {
        Unit u; int i = 0;
        for (; i < GT_MAX && S.next(i, u); ++i) {
            if (GATHER && tid < 256) gtab[i * 256 + tid] = g.gather[u.pm * BM + tid];
            if (GROUPED && tid == 0) etab[i] = g.blk_e[u.pm];
        }
        __syncthreads();
    }
    const unsigned ldsw = (unsigned)wid * 1024u;
    const int aoff = lds_byte(wr * 64 + fr, fq * 8), boff = lds_byte(wc * 32 + fr, fq * 8);
#define PG8_SA(b, h) (((b) * 2 + (h)) * HTB)
#define PG8_SB(b, h) ((4 + (b) * 2 + (h)) * HTB)
#define PG8_STAGE(bufoff, gbase, voff) do { _Pragma("unroll") for (int _i = 0; _i < 2; ++_i) \
        __builtin_amdgcn_global_load_lds((const unsigned*)((const char*)(gbase) + (voff)[_i]), (PG8_LAS unsigned*)(lds + (bufoff) + ldsw + _i * 8192), 16, 0, 0); } while (0)
#define PG8_LDA(dst, b, h) do { _Pragma("unroll") for (int m = 0; m < 4; ++m) _Pragma("unroll") for (int k = 0; k < 2; ++k) dst[m][k] = *(const PG8_LAS bf16x8*)(lds + PG8_SA(b, h) + aoff + m * 2048 + k * 1024); } while (0)
#define PG8_LDB(dst, b, h) do { _Pragma("unroll") for (int n = 0; n < 2; ++n) _Pragma("unroll") for (int k = 0; k < 2; ++k) dst[n][k] = *(const PG8_LAS bf16x8*)(lds + PG8_SB(b, h) + boff + n * 2048 + k * 1024); } while (0)
#define PG8_MMA(ai, bj, At, Bt) do { __builtin_amdgcn_s_setprio(1); \
        if constexpr (FP8) { _Pragma("unroll") for (int m = 0; m < 4; ++m) _Pragma("unroll") for (int n = 0; n < 2; ++n) { \
            typedef int v4i_ __attribute__((ext_vector_type(4))); typedef int v8i_ __attribute__((ext_vector_type(8))); \
            const v8i_ a8 = __builtin_shufflevector(__builtin_bit_cast(v4i_, At[m][0]), __builtin_bit_cast(v4i_, At[m][1]), 0, 1, 2, 3, 4, 5, 6, 7); \
            const v8i_ b8 = __builtin_shufflevector(__builtin_bit_cast(v4i_, Bt[n][0]), __builtin_bit_cast(v4i_, Bt[n][1]), 0, 1, 2, 3, 4, 5, 6, 7); \
            acc[ai][bj][m][n] = __builtin_amdgcn_mfma_scale_f32_16x16x128_f8f6f4(b8, a8, acc[ai][bj][m][n], 0, 0, 0, 0x7f7f7f7f, 0, 0x7f7f7f7f); } } \
        else { _Pragma("unroll") for (int m = 0; m < 4; ++m) _Pragma("unroll") for (int n = 0; n < 2; ++n) _Pragma("unroll") for (int k = 0; k < 2; ++k) \
            acc[ai][bj][m][n] = __builtin_amdgcn_mfma_f32_16x16x32_bf16(Bt[n][k], At[m][k], acc[ai][bj][m][n], 0, 0, 0); } \
        __builtin_amdgcn_s_setprio(0); } while (0)
#define PG8_WAIT_V(n) asm volatile("s_waitcnt vmcnt(" #n ")" ::: "memory")
#define PG8_WAIT_L(n) asm volatile("s_waitcnt lgkmcnt(" #n ")" ::: "memory")
#define PG8_BAR __builtin_amdgcn_s_barrier()
#define PG8_SCHED __builtin_amdgcn_sched_barrier(0)
#define PG8_UNIT_ADDR(u, ui_, ao, b0) do { \
        _Pragma("unroll") for (int h = 0; h < 2; ++h) _Pragma("unroll") for (int i = 0; i < 2; ++i) { int R_, C_; stage_rc(tid * 16 + i * 8192, R_, C_); \
            int row_ = (u).pm * BM + h * HALF + R_; if (GATHER) row_ = gtab[(ui_) * 256 + h * HALF + R_]; \
            ao[h][i] = (unsigned)(row_ * KB + C_ * 2); } \
        const int e_ = GROUPED ? __builtin_amdgcn_readfirstlane(etab[(ui_)]) : 0; \
        b0 = (const char*)g.B0 + (size_t)e_ * ESTRIDE + (size_t)(u).pn * BN_ROWS * KB; } while (0)
    Unit cur, nxt; int ui = 0;
    if (!S.next(0, cur)) return;
    f32x4 acc[2][2][4][2];
#pragma unroll
    for (int a = 0; a < 2; ++a)
#pragma unroll
        for (int b = 0; b < 2; ++b)
#pragma unroll
            for (int m = 0; m < 4; ++m)
#pragma unroll
                for (int n = 0; n < 2; ++n) acc[a][b][m][n] = (f32x4){0.f, 0.f, 0.f, 0.f};
    bf16x8 At[4][2], B0[2][2], B1[2][2];
    unsigned aC[2][2]; const char *cB0, *nB0; constexpr size_t bh = (size_t)BHSTEP;
    const char* gA = (const char*)g.A;
    PG8_UNIT_ADDR(cur, 0, aC, cB0);
    const size_t kstep = (size_t)(BK * 2);
    PG8_STAGE(PG8_SB(0, 0), cB0, voffB); PG8_STAGE(PG8_SB(0, 1), cB0 + bh, voffB); PG8_STAGE(PG8_SA(0, 0), gA, aC[0]); PG8_STAGE(PG8_SA(0, 1), gA, aC[1]);
    if (wr == 1) PG8_BAR;
    PG8_WAIT_V(2); PG8_BAR;
    PG8_STAGE(PG8_SB(1, 0), cB0 + kstep, voffB); PG8_STAGE(PG8_SA(1, 0), gA + kstep, aC[0]); PG8_STAGE(PG8_SB(1, 1), cB0 + bh + kstep, voffB);
    PG8_WAIT_V(6); PG8_BAR;
    for (;;) {
        const bool has_next = S.next(ui + 1, nxt);
        nB0 = cB0;
        for (int t = 0; t < nt; t += 2) {
            const bool last = (t == nt - 2);
            const char* a1 = gA + (size_t)(t + 1) * kstep;
            const char* a2 = last ? gA : gA + (size_t)(t + 2) * kstep; const char* a3 = a2 + kstep;
            PG8_LDB(B0, 0, 0); PG8_LDB(B1, 0, 1); PG8_SCHED; PG8_LDA(At, 0, 0); PG8_STAGE(PG8_SA(1, 1), a1, aC[1]);
            PG8_WAIT_V(8); PG8_WAIT_L(0); PG8_BAR; PG8_MMA(0, 0, At, B0); PG8_MMA(0, 1, At, B1); PG8_BAR; PG8_SCHED;
            if (last && has_next) { PG8_UNIT_ADDR(nxt, ui + 1, aC, nB0); }
            const char* b20 = last ? nB0 : cB0 + (size_t)(t + 2) * kstep; const char* b30 = b20 + kstep;
            PG8_LDA(At, 0, 1); PG8_STAGE(PG8_SB(0, 0), b20, voffB); PG8_STAGE(PG8_SB(0, 1), b20 + bh, voffB); PG8_STAGE(PG8_SA(0, 0), a2, aC[0]);
            PG8_WAIT_V(8); PG8_WAIT_L(0); PG8_BAR; PG8_MMA(1, 0, At, B0); PG8_MMA(1, 1, At, B1); PG8_BAR; PG8_SCHED;
            PG8_LDB(B0, 1, 0); PG8_LDB(B1, 1, 1); PG8_SCHED; PG8_LDA(At, 1, 0); PG8_STAGE(PG8_SA(0, 1), a2, aC[1]);
            PG8_WAIT_V(8); PG8_WAIT_L(0); PG8_BAR; PG8_MMA(0, 0, At, B0); PG8_MMA(0, 1, At, B1); PG8_BAR; PG8_SCHED;
            PG8_LDA(At, 1, 1); PG8_STAGE(PG8_SB(1, 0), b30, voffB); PG8_STAGE(PG8_SB(1, 1), b30 + bh, voffB); PG8_STAGE(PG8_SA(1, 0), a3, aC[0]);
            PG8_WAIT_V(8); PG8_WAIT_L(0); PG8_BAR; PG8_MMA(1, 0, At, B0); PG8_MMA(1, 1, At, B1); PG8_BAR; PG8_SCHED;
        }
        if (ALIGN) { if (wr == 0) PG8_BAR; }
        { int t2 = tid; asm volatile("" : "+v"(t2));
          E(acc, cur, wr, wc, t2 & 15, (t2 & 63) >> 4); }
        if (!has_next) break;
#pragma unroll
        for (int a = 0; a < 2; ++a)
#pragma unroll
            for (int b = 0; b < 2; ++b)
#pragma unroll
                for (int m = 0; m < 4; ++m)
#pragma unroll
                    for (int n = 0; n < 2; ++n) acc[a][b][m][n] = (f32x4){0.f, 0.f, 0.f, 0.f};
        cur = nxt; cB0 = nB0; ++ui;
        if (ALIGN) { if (wr == 1) PG8_BAR; }
    }
    PG8_WAIT_V(0);
    if (!ALIGN) { if (wr == 0) PG8_BAR; }
    PG8_BAR;
#undef PG8_SA
#undef PG8_SB
#undef PG8_STAGE
#undef PG8_LDA
#undef PG8_LDB
#undef PG8_MMA
#undef PG8_WAIT_V
#undef PG8_WAIT_L
#undef PG8_BAR
#undef PG8_SCHED
#undef PG8_UNIT_ADDR
}
}

namespace att {
using bf16x8 = __attribute__((ext_vector_type(8))) short;
using s16x4 = __attribute__((ext_vector_type(4))) short;
using f32x16 = __attribute__((ext_vector_type(16))) float;
using u32x4 = __attribute__((ext_vector_type(4))) unsigned;
typedef __attribute__((address_space(3))) const char* lds_cptr;
typedef __attribute__((address_space(3))) char* lds_ptr;
typedef short v4i16_t __attribute__((ext_vector_type(4)));
typedef float f32x2_t __attribute__((ext_vector_type(2))); typedef __bf16 bf16x2_t __attribute__((ext_vector_type(2)));
__device__ __forceinline__ int crow(int r, int hi) { return (r & 3) + 8 * (r >> 2) + 4 * hi; }
__device__ __forceinline__ unsigned cvtpk_s(float lo, float hi) { f32x2_t v = {lo, hi}; bf16x2_t b = __builtin_convertvector(v, bf16x2_t); return __builtin_bit_cast(unsigned, b); }
__device__ __forceinline__ void glds16(const void* gsrc, unsigned lds_dst) { unsigned keep;
    asm volatile("s_mov_b32 %0, m0\n\ts_mov_b32 m0, %2\n\ts_nop 0\n\tglobal_load_lds_dwordx4 %1, off\n\ts_mov_b32 m0, %0" : "=&s"(keep) : "v"(gsrc), "s"(lds_dst) : "memory"); }
__device__ __forceinline__ s16x4 vtr(lds_cptr p) { return __builtin_bit_cast(s16x4, __builtin_amdgcn_ds_read_tr16_b64_v4i16((__attribute__((address_space(3))) v4i16_t*)p)); }
#define ATT_WAIT_BAR(N) asm volatile("s_waitcnt vmcnt(" #N ") lgkmcnt(0)\n\ts_barrier" ::: "memory")

struct St { f32x16 o0, o1; float m, l; };
__device__ __forceinline__ float xhalf_max(float v) { auto rr = __builtin_amdgcn_permlane32_swap(__float_as_uint(v), __float_as_uint(v), false, false); return fmaxf(__uint_as_float(rr[0]), __uint_as_float(rr[1])); }
__device__ __forceinline__ float xhalf_sum(float v) { auto rr = __builtin_amdgcn_permlane32_swap(__float_as_uint(v), __float_as_uint(v), false, false); return __uint_as_float(rr[0]) + __uint_as_float(rr[1]); }

__device__ __forceinline__ f32x16 qk32(const bf16x8 (&qr)[4], lds_cptr kimg, const f32x16& c0, int lane) {
    const int r32 = lane & 31, hi = lane >> 5;
    const lds_cptr kr = kimg + r32 * 128; const int y = hi ^ ((r32 >> 1) & 7);
    const bf16x8 k0 = *(const __attribute__((address_space(3))) bf16x8*)(kr + ((0 ^ y) << 4)), k1 = *(const __attribute__((address_space(3))) bf16x8*)(kr + ((2 ^ y) << 4)),
                 k2 = *(const __attribute__((address_space(3))) bf16x8*)(kr + ((4 ^ y) << 4)), k3 = *(const __attribute__((address_space(3))) bf16x8*)(kr + ((6 ^ y) << 4));
    f32x16 p = __builtin_amdgcn_mfma_f32_32x32x16_bf16(k0, qr[0], c0, 0, 0, 0);
    p = __builtin_amdgcn_mfma_f32_32x32x16_bf16(k1, qr[1], p, 0, 0, 0);
    p = __builtin_amdgcn_mfma_f32_32x32x16_bf16(k2, qr[2], p, 0, 0, 0);
    p = __builtin_amdgcn_mfma_f32_32x32x16_bf16(k3, qr[3], p, 0, 0, 0);
    return p;
}
template <int NB>
__device__ __forceinline__ void softmax_upd(St& s, f32x16 (&p)[NB], bf16x8 (&pa)[2 * NB]) {
    float mx = p[0][0];
#pragma unroll
    for (int b = 0; b < NB; ++b)
#pragma unroll
        for (int r = 0; r < 16; ++r) mx = fmaxf(mx, p[b][r]);
    mx = xhalf_max(mx);
    const float mnew = fmaxf(s.m, mx);
    const float f = __builtin_amdgcn_exp2f(s.m - mnew);
    s.m = mnew;
#pragma unroll
    for (int r = 0; r < 16; ++r) { s.o0[r] *= f; s.o1[r] *= f; }
    float sum = 0.f;
#pragma unroll
    for (int b = 0; b < NB; ++b)
#pragma unroll
        for (int r = 0; r < 16; ++r) { p[b][r] = __builtin_amdgcn_exp2f(p[b][r] - mnew); sum += p[b][r]; }
    s.l = s.l * f + sum;
#pragma unroll
    for (int b = 0; b < NB; ++b) { u32x4 w0, w1;
        w0[0] = cvtpk_s(p[b][0], p[b][1]); w0[1] = cvtpk_s(p[b][2], p[b][3]); w0[2] = cvtpk_s(p[b][4], p[b][5]); w0[3] = cvtpk_s(p[b][6], p[b][7]);
        w1[0] = cvtpk_s(p[b][8], p[b][9]); w1[1] = cvtpk_s(p[b][10], p[b][11]); w1[2] = cvtpk_s(p[b][12], p[b][13]); w1[3] = cvtpk_s(p[b][14], p[b][15]);
        pa[2 * b] = __builtin_bit_cast(bf16x8, w0); pa[2 * b + 1] = __builtin_bit_cast(bf16x8, w1); }
}
__device__ __forceinline__ void pv32(St& s, const bf16x8& pa0, const bf16x8& pa1, lds_cptr vimg, int lane) {
    const int hi = lane >> 5;
    const int b1 = (lane >> 3) & 1;
    const lds_cptr vp = vimg + (4 * hi + ((lane & 15) >> 2)) * 128 + ((lane >> 4) & 1) * 32 + (lane & 3) * 8;
    const lds_cptr vpd[2] = {vp + (b1 << 6), vp + ((b1 ^ 1) << 6)};
#define ATT_VF(dh, ks) ({ const s16x4 lo_ = vtr(vpd[dh] + (ks) * 2048), hi_ = vtr(vpd[dh] + (ks) * 2048 + 1024); (bf16x8){lo_[0], lo_[1], lo_[2], lo_[3], hi_[0], hi_[1], hi_[2], hi_[3]}; })
    const bf16x8 v00 = ATT_VF(0, 0), v10 = ATT_VF(1, 0), v01 = ATT_VF(0, 1), v11 = ATT_VF(1, 1);
    s.o0 = __builtin_amdgcn_mfma_f32_32x32x16_bf16(v00, pa0, s.o0, 0, 0, 0);
    s.o1 = __builtin_amdgcn_mfma_f32_32x32x16_bf16(v10, pa0, s.o1, 0, 0, 0);
    s.o0 = __builtin_amdgcn_mfma_f32_32x32x16_bf16(v01, pa1, s.o0, 0, 0, 0);
    s.o1 = __builtin_amdgcn_mfma_f32_32x32x16_bf16(v11, pa1, s.o1, 0, 0, 0);
#undef ATT_VF
}

template <class RowPtr>
__device__ __forceinline__ void finish(St& s, __attribute__((address_space(3))) bf16* stg, int lane, const RowPtr& rowptr) {
    const int r32 = lane & 31, hi = lane >> 5;
    s.l = xhalf_sum(s.l);
    const float il = __builtin_amdgcn_rcpf(s.l);
    typedef unsigned u32x2 __attribute__((ext_vector_type(2)));
#pragma unroll
    for (int g = 0; g < 4; ++g) {
        u32x2 w0, w1;
        w0[0] = cvtpk_s(s.o0[4 * g] * il, s.o0[4 * g + 1] * il); w0[1] = cvtpk_s(s.o0[4 * g + 2] * il, s.o0[4 * g + 3] * il);
        w1[0] = cvtpk_s(s.o1[4 * g] * il, s.o1[4 * g + 1] * il); w1[1] = cvtpk_s(s.o1[4 * g + 2] * il, s.o1[4 * g + 3] * il);
        *(__attribute__((address_space(3))) u32x2*)(stg + r32 * 64 + 4 * ((2 * g + hi) ^ (2 * (r32 & 7)))) = w0;
        *(__attribute__((address_space(3))) u32x2*)(stg + r32 * 64 + 4 * ((8 + 2 * g + hi) ^ (2 * (r32 & 7)))) = w1; }
    asm volatile("s_waitcnt lgkmcnt(0)" ::: "memory");
#pragma unroll
    for (int i = 0; i < 4; ++i) { const int row = i * 8 + (lane >> 3), ch = lane & 7; const u32x4 v = *(const __attribute__((address_space(3))) u32x4*)(stg + row * 64 + 8 * (ch ^ (row & 7)));
        __builtin_nontemporal_store(v, (u32x4*)(rowptr(row) + ch * 8)); }
    asm volatile("s_waitcnt lgkmcnt(0)" ::: "memory");
}

template <int NB>
__device__ __forceinline__ void att_step(St& s, float& ref, float& fprev, const bf16x8 (&qr)[4], lds_cptr kimg, lds_cptr vimg, unsigned bw0, unsigned bw1, const f32x16& c0, const f32x16& c1, int lane) {
    const int hi = lane >> 5;
    const unsigned one2 = 0x3f803f80u;
    const unsigned nrh = f2bf(-ref); const unsigned nrl = f2bf(-ref - __uint_as_float(nrh << 16));
    u32x4 qxw = {one2, nrh | (nrl << 16), 0u, 0u}; u32x4 kx0w = {bw0, one2, 0u, 0u}; u32x4 kx1w = {bw1, one2, 0u, 0u};
    if (hi) { qxw = (u32x4){0u, 0u, 0u, 0u}; kx0w = qxw; kx1w = qxw; }
    const bf16x8 qx = __builtin_bit_cast(bf16x8, qxw), kx0 = __builtin_bit_cast(bf16x8, kx0w), kx1 = __builtin_bit_cast(bf16x8, kx1w);
    f32x16 p[NB];
    p[0] = qk32(qr, kimg, c0, lane); if (NB == 2) p[NB - 1] = qk32(qr, kimg + 4096, c1, lane);
    p[0] = __builtin_amdgcn_mfma_f32_32x32x16_bf16(kx0, qx, p[0], 0, 0, 0);
    if (NB == 2) p[NB - 1] = __builtin_amdgcn_mfma_f32_32x32x16_bf16(kx1, qx, p[NB - 1], 0, 0, 0);
#pragma unroll
    for (int r = 0; r < 16; ++r) { s.o0[r] *= fprev; s.o1[r] *= fprev; }
    float mx = p[0][0];
#pragma unroll
    for (int b = 0; b < NB; ++b)
#pragma unroll
        for (int r = 0; r < 16; ++r) mx = fmaxf(mx, p[b][r]);
    mx = xhalf_max(mx);
    float sum = 0.f;
#pragma unroll
    for (int b = 0; b < NB; ++b)
#pragma unroll
        for (int r = 0; r < 16; ++r) { p[b][r] = __builtin_amdgcn_exp2f(p[b][r]); sum += p[b][r]; }
    s.l = s.l * fprev + sum;
    const float d = fmaxf(mx, 0.f); ref += d; fprev = __builtin_amdgcn_exp2f(-d);
    bf16x8 pa[2 * NB];
#pragma unroll
    for (int b = 0; b < NB; ++b) { u32x4 w0, w1;
        w0[0] = cvtpk_s(p[b][0], p[b][1]); w0[1] = cvtpk_s(p[b][2], p[b][3]); w0[2] = cvtpk_s(p[b][4], p[b][5]); w0[3] = cvtpk_s(p[b][6], p[b][7]);
        w1[0] = cvtpk_s(p[b][8], p[b][9]); w1[1] = cvtpk_s(p[b][10], p[b][11]); w1[2] = cvtpk_s(p[b][12], p[b][13]); w1[3] = cvtpk_s(p[b][14], p[b][15]);
        pa[2 * b] = __builtin_bit_cast(bf16x8, w0); pa[2 * b + 1] = __builtin_bit_cast(bf16x8, w1); }
    pv32(s, pa[0], pa[1], vimg, lane); if (NB == 2) pv32(s, pa[2 * NB - 2], pa[2 * NB - 1], vimg + 4096, lane);
}

constexpr int L_K = 0, L_V = 49152;
constexpr int FOX_SLOT = 16384;
constexpr int L_KB = 49152;
constexpr int L_RED = 65536;
constexpr int L_WSF = 98304;
constexpr int L_OST = 100352;
constexpr int L_END = L_OST + 32768;

struct DilU { int b, h, br, rr, rho, j; };
__device__ __forceinline__ DilU dil_decode(int u) {
    DilU d; const int bh = u / 48, r = u % 48; d.b = bh / 12; d.h = bh % 12;
    if (r < 16) { d.br = 0; d.rr = 1; d.rho = 0; d.j = r; } else if (r < 32) { d.br = 1; d.rr = 4; d.rho = (r - 16) >> 2; d.j = (r - 16) & 3; } else { d.br = 2; d.rr = 16; d.rho = r - 32; d.j = 0; }
    return d;
}
__device__ __forceinline__ void dil_issue(const DilU& u, const bf16* Z, int tid, u32x4 (&kv)[12], u32x4 (&qv)[4]) {
    const size_t hb = ((size_t)(u.b * HD_DIL + u.h) * S) * 64;
    const int e0 = 256 * u.j - 128, c = tid & 7;
    const bf16* r0 = Z + hb + (size_t)u.rho * 64 + c * 8;
    const ptrdiff_t est = (ptrdiff_t)u.rr * 64;
    const bf16* rp = r0 + (ptrdiff_t)(e0 + (tid >> 3)) * est;
#pragma unroll
    for (int i = 0; i < 6; ++i) { const bf16* p = (u.j == 0 && i < 2) ? r0 : rp + (ptrdiff_t)(64 * i) * est;
        kv[i] = *(const u32x4*)(p + RKA); kv[6 + i] = *(const u32x4*)(p + RVA); }
    const bf16* qp = rp + (ptrdiff_t)128 * est + RQA;
#pragma unroll
    for (int i = 0; i < 4; ++i) qv[i] = *(const u32x4*)(qp + (ptrdiff_t)(64 * i) * est);
}
__device__ __forceinline__ void dil_commit(char* shm, int tid, const u32x4 (&kv)[12], const u32x4 (&qv)[4]) {
    const lds_ptr base = (lds_ptr)shm; const int c = tid & 7;
#pragma unroll
    for (int i = 0; i < 6; ++i) { const int row = (tid >> 3) + 64 * i;
        *(__attribute__((address_space(3))) u32x4*)(base + L_K + row * 128 + ((c ^ ((row >> 1) & 7)) << 4)) = kv[i];
        *(__attribute__((address_space(3))) u32x4*)(base + L_V + row * 128 + ((c ^ (((row >> 1) & 1) << 2)) << 4)) = kv[6 + i]; }
#pragma unroll
    for (int i = 0; i < 4; ++i) { const int row = (tid >> 3) + 64 * i;
        *(__attribute__((address_space(3))) u32x4*)(base + L_OST + row * 128 + ((c ^ ((row >> 1) & 7)) << 4)) = qv[i]; }
}
__device__ __forceinline__ void dil_qfrag(char* shm, int tid, bf16x8 (&qr)[4]) {
    const int lane = tid & 63, r32 = lane & 31, hi = lane >> 5, wid = tid >> 6; const int y = hi ^ ((r32 >> 1) & 7);
    const lds_cptr qrow = (lds_cptr)shm + L_OST + (32 * wid + r32) * 128;
#pragma unroll
    for (int d0 = 0; d0 < 4; ++d0) qr[d0] = *(const __attribute__((address_space(3))) bf16x8*)(qrow + (((2 * d0) ^ y) << 4));
}
__device__ __forceinline__ void dil_compute(const DilU& u, const bf16x8 (&qr)[4], bf16* OP, float* ML, char* shm, int tid, const float bk2) {
    const int lane = tid & 63, r32 = lane & 31, hi = lane >> 5; const int wid = __builtin_amdgcn_readfirstlane(tid >> 6);
    const lds_cptr shm3 = (lds_cptr)shm;
    __attribute__((address_space(3))) bf16* stg = (__attribute__((address_space(3))) bf16*)(shm3 + L_OST) + wid * 2048;
    const lds_cptr kw = shm3 + L_K + 32 * wid * 128, vw = shm3 + L_V + 32 * wid * 128;
    const int nlive0 = (u.j == 0) ? 4 - wid : 0;
    float qs = 0.f;
#pragma unroll
    for (int d0 = 0; d0 < 4; ++d0) { const u32x4 w = __builtin_bit_cast(u32x4, qr[d0]);
#pragma unroll
        for (int j = 0; j < 4; ++j) { const float lo = __uint_as_float(w[j] << 16), hi_ = __uint_as_float(w[j] & 0xffff0000u); qs += lo * lo + hi_ * hi_; } }
    qs = xhalf_sum(qs);
    const bool fast = !__any(!(qs * bk2 * 1.05f <= 4096.f));
    St s; s.o0 = f32x16{}; s.o1 = f32x16{}; s.m = 0.f; s.l = 0.f;
    float mref = 0.f, lscale = 1.f;
    if (fast) {
#pragma unroll
        for (int b = 0; b < 5; ++b) {
            if (b < nlive0) continue;
            f32x16 c;
#pragma unroll
            for (int r = 0; r < 16; ++r) c[r] = (b == 0 && r32 > crow(r, hi)) || (b == 4 && r32 < crow(r, hi)) ? -INFINITY : 0.f;
            f32x16 p = qk32(qr, kw + b * 4096, c, lane);
            float sum = 0.f;
#pragma unroll
            for (int r = 0; r < 16; ++r) { p[r] = __builtin_amdgcn_exp2f(p[r]); sum += p[r]; }
            s.l += sum;
            u32x4 w0, w1;
            w0[0] = cvtpk_s(p[0], p[1]); w0[1] = cvtpk_s(p[2], p[3]); w0[2] = cvtpk_s(p[4], p[5]); w0[3] = cvtpk_s(p[6], p[7]);
            w1[0] = cvtpk_s(p[8], p[9]); w1[1] = cvtpk_s(p[10], p[11]); w1[2] = cvtpk_s(p[12], p[13]); w1[3] = cvtpk_s(p[14], p[15]);
            pv32(s, __builtin_bit_cast(bf16x8, w0), __builtin_bit_cast(bf16x8, w1), vw + b * 4096, lane);
        }
    } else {
        float ref = sqrtf(qs * bk2 * 1.05f), fprev = 1.f;
#pragma nounroll
        for (int kbi = nlive0; kbi < 5; ++kbi) {
            f32x16 c;
#pragma unroll
            for (int r = 0; r < 16; ++r) c[r] = (kbi == 0 && r32 > crow(r, hi)) || (kbi == 4 && r32 < crow(r, hi)) ? -INFINITY : 0.f;
            att_step<1>(s, ref, fprev, qr, kw + kbi * 4096, vw + kbi * 4096, 0u, 0u, c, c, lane);
        }
        mref = ref; lscale = fprev;
    }
    bf16* OPb = OP + ((size_t)u.br * T + (size_t)u.b * S) * 768 + u.h * 64;
    const int eb = 256 * u.j + 32 * wid;
    finish(s, stg, lane, [&](int q) { return OPb + (size_t)(u.rho + u.rr * (eb + q)) * 768; });
    if (hi == 0) { const int tq = u.rho + u.rr * (eb + r32); float* mp = ML + (((size_t)u.br * T + (size_t)u.b * S + tq) * 12 + u.h) * 2; mp[0] = mref; mp[1] = s.l * lscale; }
}

__device__ __forceinline__ void fox_bias(int b, int h, int n, const float* logf, char* shm, const int tid) {
    const int lane = tid & 63, wid = tid >> 6;
    __attribute__((address_space(3))) float* kb = (__attribute__((address_space(3))) float*)((lds_cptr)shm + L_KB);
    __attribute__((address_space(3))) float* red = (__attribute__((address_space(3))) float*)((lds_cptr)shm + L_RED);
    float v[8]; float tot = 0.f;
#pragma unroll
    for (int i = 0; i < 8; ++i) { const int sidx = tid * 8 + i; v[i] = sidx < n ? logf[((size_t)b * S + sidx) * 4 + h] : 0.f; tot += v[i]; v[i] = tot; }
    float inc = tot;
#pragma unroll
    for (int o = 1; o < 64; o <<= 1) { const float x = __shfl_up(inc, o); if (lane >= o) inc += x; }
    if (lane == 63) red[wid] = inc;
    __syncthreads();
    float base = inc - tot;
    for (int w = 0; w < wid; ++w) base += red[w];
#pragma unroll
    for (int i = 0; i < 8; ++i) { const float bv = -(base + v[i]) * LOG2E; const unsigned bh = f2bf(bv); const unsigned bl = f2bf(bv - __uint_as_float(bh << 16));
        kb[tid * 8 + i] = __uint_as_float(bh | (bl << 16)); }
    __syncthreads();
}

template <bool DIAG>
__device__ __forceinline__ void fox_tile(St& s, float& ref, float& fprev, const bf16x8 (&qr)[4], lds_cptr kimg, lds_cptr vimg, lds_cptr kbias_t, int qrel  , const f32x16& zero16, int lane) {
    const int r32 = lane & 31, hi = lane >> 5;
    const unsigned bw0 = __float_as_uint(*(const __attribute__((address_space(3))) float*)(kbias_t + r32 * 4)), bw1 = __float_as_uint(*(const __attribute__((address_space(3))) float*)(kbias_t + (32 + r32) * 4));
    f32x16 c0 = zero16, c1 = zero16;
    if (DIAG) {
#pragma unroll
        for (int r = 0; r < 16; ++r) { const int k = crow(r, hi); c0[r] = k > qrel ? -INFINITY : 0.f; c1[r] = k + 32 > qrel ? -INFINITY : 0.f; }
    }
    att_step<2>(s, ref, fprev, qr, kimg, vimg, bw0, bw1, c0, c1, lane);
}
__device__ __forceinline__ void fox_unit(int b, int h, int qb, const bf16* Z, bf16* OF, char* shm, const int tid, const float bk2) {
    const int lane = tid & 63, r32 = lane & 31, hi = lane >> 5; const int wid = __builtin_amdgcn_readfirstlane(tid >> 6);
    const unsigned lds0 = (unsigned)(uintptr_t)shm;
    const lds_cptr shm3 = (lds_cptr)shm;
    __attribute__((address_space(3))) bf16* stg = (__attribute__((address_space(3))) bf16*)(shm3 + L_OST) + wid * 2048;
    const lds_cptr kbias = shm3 + L_KB;
    const size_t hb = ((size_t)(b * HD_FOX + h) * S) * 64;
    const int q0 = qb * 256;
    const int NTw = (q0 + 32 * wid) / 64 + 1;
    const int NT = (q0 + 256) / 64;
    const int drow = 8 * wid + (lane >> 3);
    const bf16* ksrc = Z + RKF + hb + (size_t)drow * 64 + (((lane & 7) ^ ((drow >> 1) & 7)) << 3);
    const bf16* vsrc = Z + RVF + hb + (size_t)drow * 64 + (((lane & 7) ^ (((drow >> 1) & 1) << 2)) << 3);
    const unsigned kdst = lds0 + L_K + wid * 1024, vdst = lds0 + L_K + 8192 + wid * 1024;
#define FOX_DMA(t, slot) do { glds16(ksrc + (size_t)(t) * 64 * 64, (unsigned)__builtin_amdgcn_readfirstlane(kdst + (slot) * FOX_SLOT)); \
                              glds16(vsrc + (size_t)(t) * 64 * 64, (unsigned)__builtin_amdgcn_readfirstlane(vdst + (slot) * FOX_SLOT)); } while (0)
    const int qrow = q0 + 32 * wid + r32;
    bf16x8 qr[4];
#pragma unroll
    for (int d0 = 0; d0 < 4; ++d0) qr[d0] = *(const bf16x8*)(Z + RQF + hb + (size_t)qrow * 64 + d0 * 16 + hi * 8);
    int t0; float ref0;
    { float qs = 0.f;
#pragma unroll
      for (int d0 = 0; d0 < 4; ++d0) { const u32x4 w = __builtin_bit_cast(u32x4, qr[d0]);
#pragma unroll
          for (int j = 0; j < 4; ++j) { const float lo = __uint_as_float(w[j] << 16), hi_ = __uint_as_float(w[j] & 0xffff0000u); qs += lo * lo + hi_ * hi_; } }
      qs = xhalf_sum(qs);
#pragma unroll
      for (int o = 1; o < 32; o <<= 1) qs = fmaxf(qs, __shfl_xor(qs, o));
      __attribute__((address_space(3))) float* red = (__attribute__((address_space(3))) float*)(shm3 + L_RED);
      if (lane == 0) red[wid] = qs;
      asm volatile("s_waitcnt lgkmcnt(0)\n\ts_barrier" ::: "memory");
      float bq2 = red[0];
#pragma unroll
      for (int w = 1; w < 8; ++w) bq2 = fmaxf(bq2, red[w]);
      const float th = 64.f + 2.05f * sqrtf(bq2 * bk2) + 2.f;
      const float* kbf = (const float*)0; (void)kbf;
      auto kbv = [&](int key) { const unsigned w = __float_as_uint(*(const __attribute__((address_space(3))) float*)(kbias + key * 4)); return __uint_as_float(w << 16) + __uint_as_float(w & 0xffff0000u); };
      const float kq0 = kbv(q0);
      t0 = 0;
      while (t0 < 4 * qb && kq0 - kbv(64 * t0 + 63) > th) ++t0;
      t0 = __builtin_amdgcn_readfirstlane(t0);
#ifdef FOX_NOPRUNE
      t0 = 0;
#endif
#ifdef FOX_FORCE2
      t0 = 4 * qb < 2 ? 4 * qb : 2;
#endif
      ref0 = kbv(64 * t0);
      asm volatile("s_waitcnt lgkmcnt(0)\n\ts_barrier" ::: "memory");
    }
    FOX_DMA(t0, 0); if (t0 + 1 < NT) FOX_DMA(t0 + 1, 1);
    St s; s.o0 = f32x16{}; s.o1 = f32x16{}; s.m = 0.f; s.l = 0.f;
    float ref = ref0, fprev = 1.f;
    f32x16 zero16 = f32x16{}; asm volatile("" : "+v"(zero16));
    asm volatile("" : "+v"(qr[0]), "+v"(qr[1]), "+v"(qr[2]), "+v"(qr[3]));
    asm volatile("s_waitcnt vmcnt(0)" ::: "memory");
    int slot = 0;
    for (int t = t0; t < NT; ++t) {
        if (t + 1 < NT && t > t0) { ATT_WAIT_BAR(2); } else { ATT_WAIT_BAR(0); }
        if (t + 2 < NT) { const int s2 = slot == 0 ? 2 : slot - 1; FOX_DMA(t + 2, s2); }
        const lds_cptr kt = shm3 + L_K + slot * FOX_SLOT, vt = kt + 8192;
        if (t < NTw - 1) fox_tile<false>(s, ref, fprev, qr, kt, vt, kbias + 64 * t * 4, 0, zero16, lane);
        else if (t == NTw - 1) fox_tile<true>(s, ref, fprev, qr, kt, vt, kbias + 64 * t * 4, qrow - 64 * t, zero16, lane);
        slot = slot == 2 ? 0 : slot + 1;
    }
#undef FOX_DMA
    bf16* OFb = OF + ((size_t)b * S + q0 + 32 * wid) * 256 + h * 64;
    finish(s, stg, lane, [&](int q) { return OFb + (size_t)q * 256; });
    asm volatile("s_waitcnt lgkmcnt(0)\n\ts_barrier" ::: "memory");
}
}

constexpr int NWAVES = 8;
constexpr int RING_BYTES = 131072;
constexpr int MISC_OFF = pg8::ETAB_OFF + 256;
constexpr int LDS_BYTES = 147456;
static_assert(MISC_OFF + 256 <= LDS_BYTES && att::L_END <= MISC_OFF, "LDS map");

#define GAS __attribute__((address_space(1)))
#define LAS __attribute__((address_space(3)))
#include <type_traits>
typedef unsigned v4u __attribute__((ext_vector_type(4)));
typedef float f32x4 __attribute__((ext_vector_type(4)));
typedef GAS unsigned gu32;
#define RLX_AGENT __ATOMIC_RELAXED, __HIP_MEMORY_SCOPE_AGENT
#define LDS_WAIT() asm volatile("s_waitcnt lgkmcnt(0)" ::: "memory")

#define XB_TMO      128
#define XB_XCNT(j)  (256  + 64 * (j))
#define XB_XSUB(j)  (1280 + 64 * (j))
#define XB_XGEN(j)  (2304 + 64 * (j))
#define XB_TOP      3328
#define XB_TOPGEN   3392
#define XCD_BAR_WORDS 3456
#define XB_SPIN_CAP (1u << 20)
__device__ __forceinline__ unsigned xb_ld(unsigned* p)              { return __hip_atomic_load(p, __ATOMIC_RELAXED, __HIP_MEMORY_SCOPE_AGENT); }
__device__ __forceinline__ unsigned xb_add(unsigned* p, unsigned v) { return __hip_atomic_fetch_add(p, v, __ATOMIC_RELAXED, __HIP_MEMORY_SCOPE_AGENT); }
__device__ __forceinline__ unsigned xb_xcc_id() { return (unsigned)__builtin_amdgcn_s_getreg((3 << 11) | 20) & 0xFu; }
#define XB_SPIN(cond, bar) do { unsigned _sp = 0; while (cond) { __builtin_amdgcn_s_sleep(1); \
    if ((++_sp & 255u) == 0u) { if (xb_ld(&(bar)[XB_TMO])) break; if (_sp > XB_SPIN_CAP) { atomicAdd(&(bar)[XB_TMO], 1u); break; } } } } while (0)
struct XcdBarrier { unsigned* bar; unsigned x; volatile LAS unsigned* st; };
__device__ __forceinline__ XcdBarrier xcd_barrier_post(unsigned* bar, volatile LAS unsigned* st, bool t0) {
    XcdBarrier b; b.bar = bar; b.x = xb_xcc_id(); b.st = st;
    if (t0) (void)xb_add(&bar[XB_XCNT(b.x)], 1u);
    return b;
}
__device__ __forceinline__ void xcd_barrier_complete(unsigned* bar, unsigned x, unsigned& nloc, unsigned& nx) {
    const unsigned G = gridDim.x * gridDim.y * gridDim.z;
    unsigned sum, cnt, mine, sp = 0u;
    for (;;) {
        sum = 0u; cnt = 0u; mine = 0u;
#pragma unroll
        for (unsigned j = 0; j < 16; ++j) { const unsigned c = xb_ld(&bar[XB_XCNT(j)]); sum += c; cnt += (c > 0u) ? 1u : 0u; mine = (j == x) ? c : mine; }
        if (sum == G) break;
        __builtin_amdgcn_s_sleep(1);
        if ((++sp & 255u) == 0u) { if (xb_ld(&bar[XB_TMO])) break; if (sp > XB_SPIN_CAP) { atomicAdd(&bar[XB_TMO], 1u); break; } }
    }
    nloc = mine > 0u ? mine : 1u; nx = cnt > 0u ? cnt : 1u;
}
__device__ __forceinline__ void xcd_barrier(const XcdBarrier& b, bool t0) {
    asm volatile("s_waitcnt vmcnt(0)" ::: "memory");
    __syncthreads();
    if (t0) {
        unsigned* bar = b.bar;
        __builtin_amdgcn_s_waitcnt(0);
        unsigned nloc = b.st[0], nx = b.st[1];
        if (nloc == 0u) { xcd_barrier_complete(bar, b.x, nloc, nx); b.st[0] = nloc; b.st[1] = nx; }
        const unsigned old = xb_add(&bar[XB_XSUB(b.x)], 1u);
        const unsigned gen = old / nloc;
        if (old + 1u == (gen + 1u) * nloc) {
            __builtin_amdgcn_fence(__ATOMIC_RELEASE, "agent");
            asm volatile("s_waitcnt vmcnt(0)" ::: "memory");
            const unsigned og = xb_add(&bar[XB_TOP], 1u);
            const unsigned tg = og / nx; const bool lastx = (og + 1u == (tg + 1u) * nx);
            asm volatile("buffer_inv sc1" ::: "memory");
            if (lastx) xb_add(&bar[XB_TOPGEN], 1u);
            else XB_SPIN(xb_ld(&bar[XB_TOPGEN]) == tg, bar);
            asm volatile("s_waitcnt vmcnt(0)" ::: "memory");
        } else {
            asm volatile("buffer_inv sc1" ::: "memory");
            XB_SPIN(xb_ld(&bar[XB_TOPGEN]) == gen, bar);
            asm volatile("s_waitcnt vmcnt(0)" ::: "memory");
        }
    }
    __syncthreads();
}

__device__ __forceinline__ int fresh_lane() { int l; asm volatile("v_mbcnt_lo_u32_b32 %0, -1, 0\n\tv_mbcnt_hi_u32_b32 %0, -1, %0" : "=v"(l)); return l; }
struct Args { const float* in[15]; float* out; unsigned char* ws; int ph_lo, ph_hi, li, pad; };
struct Frame { LAS unsigned char* lds; int tid, lane, wave, G, gw, NGW; };

template <int CTRL, int ROWMASK> __device__ __forceinline__ float dpp_mov(float v) { return __int_as_float(__builtin_amdgcn_update_dpp(0, __float_as_int(v), CTRL, ROWMASK, 0xF, false)); }
__device__ __forceinline__ float wave_sum(float v) {
    v += dpp_mov<0xB1, 0xF>(v);
    v += dpp_mov<0x4E, 0xF>(v);
    v += dpp_mov<0x141, 0xF>(v);
    v += dpp_mov<0x140, 0xF>(v);
    v += dpp_mov<0x142, 0xA>(v);
    v += dpp_mov<0x143, 0xC>(v);
    return __int_as_float(__builtin_amdgcn_readlane(__float_as_int(v), 63));
}
__device__ __forceinline__ void unpack8(v4u v, float* o) {
    o[0] = __uint_as_float(v.x << 16); o[1] = __uint_as_float(v.x & 0xffff0000u); o[2] = __uint_as_float(v.y << 16); o[3] = __uint_as_float(v.y & 0xffff0000u);
    o[4] = __uint_as_float(v.z << 16); o[5] = __uint_as_float(v.z & 0xffff0000u); o[6] = __uint_as_float(v.w << 16); o[7] = __uint_as_float(v.w & 0xffff0000u);
}
__device__ __forceinline__ v4u pack8(const float* o) { v4u v; v.x = pk2(o[0], o[1]); v.y = pk2(o[2], o[3]); v.z = pk2(o[4], o[5]); v.w = pk2(o[6], o[7]); return v; }

__device__ __forceinline__ void tr_load_tile(const float* W, int ldw, int k0, int n0s, LAS float* scr, int lane, float wsc) {
    const int g = lane & 7, kr = lane >> 3; f32x4 wv[8];
    const float* wp = W + (size_t)(k0 + kr) * ldw + n0s + 4 * g;
#pragma unroll
    for (int i = 0; i < 8; ++i) wv[i] = *(const GAS f32x4*)(wp + (size_t)(8 * i) * ldw);
#pragma unroll
    for (int i = 0; i < 8; ++i) *(LAS f32x4*)(scr + (8 * i + kr) * 32 + 4 * (g ^ i)) = wv[i] * wsc;
    LDS_WAIT(); asm volatile("" ::: "memory");
}
__device__ __forceinline__ void tr_item(const float* W, int ldw, int k0, int n0s, bf16* WT, int K, int n0d, LAS float* scr, int lane, float wsc = 1.f) {
    tr_load_tile(W, ldw, k0, n0s, scr, lane, wsc);
    const int c = lane & 7;
#pragma unroll
    for (int j = 0; j < 4; ++j) { const int n = (lane >> 3) + 8 * j; const LAS float* s = scr + (8 * c) * 32 + 4 * ((n >> 2) ^ c) + (n & 3);
        v4u o; o.x = pk2(s[0 * 32], s[1 * 32]); o.y = pk2(s[2 * 32], s[3 * 32]); o.z = pk2(s[4 * 32], s[5 * 32]); o.w = pk2(s[6 * 32], s[7 * 32]);
        *(GAS v4u*)(WT + (size_t)(n0d + n) * K + k0 + 8 * c) = o; }
    LDS_WAIT(); asm volatile("" ::: "memory");
}
__device__ __forceinline__ void tr_item8(const float* W, int ldw, int k0, int n0s, unsigned char* WT, int K, int n0d, LAS float* scr, int lane) {
    typedef unsigned u32x2 __attribute__((ext_vector_type(2)));
    tr_load_tile(W, ldw, k0, n0s, scr, lane, 32.f);
    const int c = lane & 7;
#pragma unroll
    for (int j = 0; j < 4; ++j) { const int n = (lane >> 3) + 8 * j; const LAS float* s = scr + (8 * c) * 32 + 4 * ((n >> 2) ^ c) + (n & 3);
        int w0 = 0, w1 = 0;
        w0 = __builtin_amdgcn_cvt_pk_fp8_f32(s[0 * 32], s[1 * 32], w0, false); w0 = __builtin_amdgcn_cvt_pk_fp8_f32(s[2 * 32], s[3 * 32], w0, true);
        w1 = __builtin_amdgcn_cvt_pk_fp8_f32(s[4 * 32], s[5 * 32], w1, false); w1 = __builtin_amdgcn_cvt_pk_fp8_f32(s[6 * 32], s[7 * 32], w1, true);
        *(GAS u32x2*)(WT + (size_t)(n0d + n) * K + k0 + 8 * c) = (u32x2){(unsigned)w0, (unsigned)w1}; }
    LDS_WAIT(); asm volatile("" ::: "memory");
}
__device__ __forceinline__ void conv_expert_mat8(const Frame& F, const float* Wl, unsigned char* WTl) {
    LAS float* scr = (LAS float*)(F.lds + F.wave * 16384);
    constexpr int PER_E = 16 * 32, NIT = NE * PER_E;
    for (int it = F.gw; it < NIT; it += F.NGW) {
        const int e = it / PER_E, q = it % PER_E, kb = q / 32, nb = q % 32;
        tr_item8(Wl + (size_t)e * D * D, D, 64 * kb, 32 * nb, WTl + (size_t)e * D * D, D, 32 * nb, scr, F.lane);
    }
}
constexpr int CQ_NCH = 3 * NE * 16 * 32 / 16;
__device__ __forceinline__ void conv_chunk8(const Frame& F, const float* wg, const float* wu, const float* wd, unsigned char* dst  , int chunk) {
    LAS float* scr = (LAS float*)(F.lds + F.wave * 16384);
#pragma unroll 1
    for (int j = 0; j < 2; ++j) {
        const int it = 16 * chunk + 8 * j + F.wave, mat = it >> 13, r = it & 8191, e = r >> 9, q = r & 511, kb = q >> 5, nb = q & 31;
        const float* W = (mat == 0 ? wg : mat == 1 ? wu : wd) + (size_t)e * D * D;
        tr_item8(W, D, 64 * kb, 32 * nb, dst + (size_t)mat * (16 * MiB) + (size_t)e * D * D, D, 32 * nb, scr, F.lane);
    }
}
__device__ __forceinline__ void conv_pull(const Frame& F, const float* wg, const float* wu, const float* wd, unsigned char* dst, int* cq, int n) {
    LAS int* mb = (LAS int*)(F.lds + MISC_OFF + 64);
    const bool t0 = F.tid == 0;
    __syncthreads();
    if (t0) { mb[0] = n > 0 ? atomicAdd(cq, 1) : CQ_NCH; mb[1] = n > 1 ? atomicAdd(cq, 1) : CQ_NCH; }
    __syncthreads();
    int cur = mb[0], nxt = mb[1];
#pragma unroll 1
    for (int i = 0; cur < CQ_NCH; ++i) {
        int fut = CQ_NCH; if (t0 && i + 2 < n) fut = atomicAdd(cq, 1);
        conv_chunk8(F, wg, wu, wd, dst, cur);
        if (t0) mb[2 + (i & 1)] = fut;
        __syncthreads();
        cur = nxt; nxt = mb[2 + (i & 1)];
    }
    __syncthreads();
}
__device__ __forceinline__ void conv_expert_mat(const Frame& F, const float* Wl, bf16* WTl) {
    LAS float* scr = (LAS float*)(F.lds + F.wave * 16384);
    constexpr int PER_E = 16 * 32, NIT = NE * PER_E;
    for (int it = F.gw; it < NIT; it += F.NGW) {
        const int e = it / PER_E, q = it % PER_E, kb = q / 32, nb = q % 32;
        tr_item(Wl + (size_t)e * D * D, D, 64 * kb, 32 * nb, WTl + (size_t)e * D * D, D, 32 * nb, scr, F.lane);
    }
}
__device__ __forceinline__ void p_prologue(const Frame& F, const float* x, const float* w_in, const float* w_out, bf16* WinT, bf16* WoutT, bf16* H0, bf16* H1, const float* bf0, float* logf) {
    LAS float* scr = (LAS float*)(F.lds + F.wave * 16384);
    for (int it = F.gw; it < 2 * 16 * 96; it += F.NGW) {
        const int l = it / (16 * 96), r = it % (16 * 96), kb = r / 96, nb = r % 96, n0d = 32 * nb, pn = n0d >> 8, bj = (n0d >> 7) & 1, c0 = n0d & 127;
        const int n0s = pn < 6 ? 256 * pn + 64 * (c0 >> 5) + 32 * bj : n0d;
        tr_item(w_in + (size_t)l * D * NPROJ, NPROJ, 64 * kb, n0s, WinT + (size_t)l * NZ * D, D, n0d, scr, F.lane, (pn < 3 || pn == 9) ? C2 : 1.f);
    }
    for (int it = F.gw; it < 2 * 16 * 32; it += F.NGW) {
        const int l = it / (16 * 32), r = it % (16 * 32), kb = r / 32, nb = r % 32;
        tr_item(w_out + (size_t)l * D * D, D, 64 * kb, 32 * nb, WoutT + (size_t)l * D * D, D, 32 * nb, scr, F.lane);
    }
    __syncthreads();
    { LAS float* wfl = (LAS float*)F.lds;
      for (int k = F.tid; k < D; k += 512) { const f32x4 w = *(const GAS f32x4*)(w_in + (size_t)k * NPROJ + NZ); wfl[k] = w.x; wfl[D + k] = w.y; wfl[2 * D + k] = w.z; wfl[3 * D + k] = w.w; }
      __syncthreads();
      f32x4 xv[2][4];
#define PRO_LOAD(slot_, m_) do { const GAS f32x4* xr_ = (const GAS f32x4*)(x + (size_t)(m_) * D) + F.lane; _Pragma("unroll") for (int j = 0; j < 4; ++j) xv[slot_][j] = xr_[64 * j]; } while (0)
      if (F.gw < T) PRO_LOAD(0, F.gw);
      if (F.gw + F.NGW < T) PRO_LOAD(1, F.gw + F.NGW);
      int par = 0;
      for (int m = F.gw; m < T; m += F.NGW, par ^= 1) {
        GAS unsigned long long* o8 = (GAS unsigned long long*)(H0 + (size_t)m * D) + F.lane;
        float acc[4] = {0.f, 0.f, 0.f, 0.f};
        f32x4 cv[4];
        if (par == 0) { _Pragma("unroll") for (int j = 0; j < 4; ++j) cv[j] = xv[0][j]; if (m + 2 * F.NGW < T) PRO_LOAD(0, m + 2 * F.NGW); }
        else { _Pragma("unroll") for (int j = 0; j < 4; ++j) cv[j] = xv[1][j]; if (m + 2 * F.NGW < T) PRO_LOAD(1, m + 2 * F.NGW); }
#pragma unroll
        for (int j = 0; j < 4; ++j) { const f32x4 v = cv[j]; o8[64 * j] = (unsigned long long)pk2(v.x, v.y) | ((unsigned long long)pk2(v.z, v.w) << 32);
#pragma unroll
            for (int q = 0; q < 4; ++q) { const f32x4 w = *(const LAS f32x4*)(wfl + q * D + 4 * F.lane + 256 * j); acc[q] += v.x * w.x + v.y * w.y + v.z * w.z + v.w * w.w; } }
#pragma unroll
        for (int q = 0; q < 4; ++q) acc[q] = wave_sum(acc[q]);
        if (F.lane < 4) { const float z = (F.lane == 0 ? acc[0] : F.lane == 1 ? acc[1] : F.lane == 2 ? acc[2] : acc[3]) + bf0[F.lane];
            logf[(size_t)m * 4 + F.lane] = fminf(z, 0.f) - log1pf(expf(-fabsf(z))); }
      }
    }
    if (blockIdx.x == 0) { for (int i = F.tid; i < D; i += 512) { H0[(size_t)T * D + i] = 0; H1[(size_t)T * D + i] = 0; } }
    __syncthreads();
}
__device__ __forceinline__ void p_merge(const Frame& F, const bf16* OP, const float* ML, const bf16* OF, const float* gd, const float* gf, bf16* YN) {
    typedef float f32x2 __attribute__((ext_vector_type(2)));
    const int lane = F.lane; const bool dil = lane < 48; const int h = lane >> 2;
    v4u ro[6]; f32x2 rm[3];
#define MG_LOAD(t_) do { if (dil) { _Pragma("unroll") for (int br = 0; br < 3; ++br) { rm[br] = *(const GAS f32x2*)(ML + (((size_t)br * T + (t_)) * 12 + h) * 2); \
            const bf16* op_ = OP + ((size_t)br * T + (t_)) * 768 + lane * 16; ro[2 * br] = *(const GAS v4u*)op_; ro[2 * br + 1] = *(const GAS v4u*)(op_ + 8); } } \
        else { const bf16* op_ = OF + (size_t)(t_) * 256 + (lane - 48) * 16; ro[0] = *(const GAS v4u*)op_; ro[1] = *(const GAS v4u*)(op_ + 8); } } while (0)
    if (F.gw < T) MG_LOAD(F.gw);
    for (int t = F.gw; t < T; t += F.NGW) {
        asm volatile("" ::: "memory");
        float v[16];
        if (dil) {
            const float M = fmaxf(rm[0].x, fmaxf(rm[1].x, rm[2].x));
            float w[3], ws = 0.f;
#pragma unroll
            for (int br = 0; br < 3; ++br) { w[br] = rm[br].y * exp2f(rm[br].x - M); ws += w[br]; }
            const float iws = 1.f / ws;
#pragma unroll
            for (int j = 0; j < 16; ++j) v[j] = 0.f;
#pragma unroll
            for (int br = 0; br < 3; ++br) { float a[16]; unpack8(ro[2 * br], a); unpack8(ro[2 * br + 1], a + 8); const float wn = w[br] * iws;
#pragma unroll
                for (int j = 0; j < 16; ++j) v[j] += wn * a[j]; }
        } else { unpack8(ro[0], v); unpack8(ro[1], v + 8); }
        if (t + F.NGW < T) MG_LOAD(t + F.NGW);
        float ss = 0.f;
#pragma unroll
        for (int j = 0; j < 16; ++j) ss += v[j] * v[j];
        const float sd = wave_sum(dil ? ss : 0.f), sf = wave_sum(dil ? 0.f : ss);
        const float r = dil ? rsqrtf(sd / 768.f + RMS_EPS) : rsqrtf(sf / 256.f + RMS_EPS);
        float o[16];
        { const float* gp = dil ? gd + lane * 16 : gf + (lane - 48) * 16; asm volatile("" : "+v"(gp));
#pragma unroll
          for (int j4 = 0; j4 < 4; ++j4) { const f32x4 g4 = *(const GAS f32x4*)(gp + 4 * j4);
#pragma unroll
            for (int jj = 0; jj < 4; ++jj) o[4 * j4 + jj] = v[4 * j4 + jj] * r * g4[jj]; } }
        *(GAS v4u*)(YN + (size_t)t * D + lane * 16) = pack8(o); *(GAS v4u*)(YN + (size_t)t * D + lane * 16 + 8) = pack8(o + 8);
    }
#undef MG_LOAD
}
__device__ __forceinline__ void p_ln1(const Frame& F, const bf16* H0, const bf16* Y1, const float* g, const float* bb, const float* w_router, const float* b_router,
                                      bf16* H1, int* toke, float* tokg, int* histg, unsigned char* H1q) {
    typedef short bf16x8_t __attribute__((ext_vector_type(8))); typedef float f32x2_t __attribute__((ext_vector_type(2)));
    LAS unsigned char* wfr = F.lds; LAS int* hist = (LAS int*)(F.lds + 65536);
    LAS f32x2_t* part = (LAS f32x2_t*)(F.lds + 65536 + 256); LAS f32x4* racc = (LAS f32x4*)(F.lds + 65536 + 4096);
    for (int it = F.tid; it < 2048; it += 512) { const int s = it >> 6, l = it & 63; float w[8];
#pragma unroll
        for (int j = 0; j < 8; ++j) w[j] = w_router[(32 * s + 8 * (l >> 4) + j) * NE + (l & 15)];
        v4u hi4, lo4;
        hi4.x = pk2(w[0], w[1]); hi4.y = pk2(w[2], w[3]); hi4.z = pk2(w[4], w[5]); hi4.w = pk2(w[6], w[7]);
        lo4.x = pk2(w[0] - __uint_as_float(hi4.x << 16), w[1] - __uint_as_float(hi4.x & 0xffff0000u)); lo4.y = pk2(w[2] - __uint_as_float(hi4.y << 16), w[3] - __uint_as_float(hi4.y & 0xffff0000u));
        lo4.z = pk2(w[4] - __uint_as_float(hi4.z << 16), w[5] - __uint_as_float(hi4.z & 0xffff0000u)); lo4.w = pk2(w[6] - __uint_as_float(hi4.w << 16), w[7] - __uint_as_float(hi4.w & 0xffff0000u));
        *(LAS v4u*)(wfr + it * 32) = hi4; *(LAS v4u*)(wfr + it * 32 + 16) = lo4; }
    if (F.tid < NE) hist[F.tid] = 0;
    if (H1q && blockIdx.x == 0 && F.tid < 256) ((GAS unsigned*)(H1q + (size_t)T * D))[F.tid] = 0u;
    __syncthreads();
    const int lane = F.lane, tk = lane & 15, kq = lane >> 4, w8 = F.wave;
    const int col0 = 128 * w8 + 8 * kq;
    const float* gp = g + col0; const float* bp = bb + col0;
    v4u lh[4], ly[4];
#define LN1_LOAD(it_) do { const size_t ro_ = (size_t)(blockIdx.x * 128 + 16 * (it_) + tk) * D + col0; \
        _Pragma("unroll") for (int i = 0; i < 4; ++i) { lh[i] = *(const GAS v4u*)(H0 + ro_ + 32 * i); ly[i] = *(const GAS v4u*)(Y1 + ro_ + 32 * i); } } while (0)
    LN1_LOAD(0);
    for (int it = 0; it < 8; ++it) {
        asm volatile("" ::: "memory");
        const int t = blockIdx.x * 128 + 16 * it + tk;
        float u[32]; float sum = 0.f, sq = 0.f;
#pragma unroll
        for (int i = 0; i < 4; ++i) { float a[8], y[8]; unpack8(lh[i], a); unpack8(ly[i], y);
#pragma unroll
            for (int j = 0; j < 8; ++j) { const float x = ALPHA * a[j] + y[j]; u[8 * i + j] = x; sum += x; sq += x * x; } }
        if (it + 1 < 8) LN1_LOAD(it + 1);
        sum += __shfl_xor(sum, 16); sum += __shfl_xor(sum, 32); sq += __shfl_xor(sq, 16); sq += __shfl_xor(sq, 32);
        LAS f32x2_t* pp = part + (it & 1) * 128;
        if (lane < 16) pp[w8 * 16 + tk] = (f32x2_t){sum, sq};
        asm volatile("s_waitcnt lgkmcnt(0)\n\ts_barrier" ::: "memory");
        float ts = 0.f, tq = 0.f;
#pragma unroll
        for (int w = 0; w < 8; ++w) { const f32x2_t p = pp[w * 16 + tk]; ts += p.x; tq += p.y; }
        const float mu = ts * (1.f / D); const float rstd = rsqrtf(fmaxf(tq * (1.f / D) - mu * mu, 0.f) + LN_EPS);
        f32x4 acc = {0.f, 0.f, 0.f, 0.f};
#pragma unroll
        for (int i = 0; i < 4; ++i) {
            const f32x4 g0 = *(const GAS f32x4*)(gp + 32 * i), g1 = *(const GAS f32x4*)(gp + 32 * i + 4), b0 = *(const GAS f32x4*)(bp + 32 * i), b1 = *(const GAS f32x4*)(bp + 32 * i + 4);
            float v[8];
#pragma unroll
            for (int j = 0; j < 8; ++j) v[j] = (u[8 * i + j] - mu) * rstd * (j < 4 ? g0[j] : g1[j - 4]) + (j < 4 ? b0[j] : b1[j - 4]);
            v4u hi4, lo4;
            hi4.x = pk2(v[0], v[1]); hi4.y = pk2(v[2], v[3]); hi4.z = pk2(v[4], v[5]); hi4.w = pk2(v[6], v[7]);
            lo4.x = pk2(v[0] - __uint_as_float(hi4.x << 16), v[1] - __uint_as_float(hi4.x & 0xffff0000u)); lo4.y = pk2(v[2] - __uint_as_float(hi4.y << 16), v[3] - __uint_as_float(hi4.y & 0xffff0000u));
            lo4.z = pk2(v[4] - __uint_as_float(hi4.z << 16), v[5] - __uint_as_float(hi4.z & 0xffff0000u)); lo4.w = pk2(v[6] - __uint_as_float(hi4.w << 16), v[7] - __uint_as_float(hi4.w & 0xffff0000u));
            *(GAS v4u*)(H1 + (size_t)t * D + col0 + 32 * i) = hi4;
            if (H1q) { typedef unsigned u32x2_ __attribute__((ext_vector_type(2))); int w0 = 0, w1 = 0;
                w0 = __builtin_amdgcn_cvt_pk_fp8_f32(v[0], v[1], w0, false); w0 = __builtin_amdgcn_cvt_pk_fp8_f32(v[2], v[3], w0, true);
                w1 = __builtin_amdgcn_cvt_pk_fp8_f32(v[4], v[5], w1, false); w1 = __builtin_amdgcn_cvt_pk_fp8_f32(v[6], v[7], w1, true);
                *(GAS u32x2_*)(H1q + (size_t)t * D + col0 + 32 * i) = (u32x2_){(unsigned)w0, (unsigned)w1}; }
            const bf16x8_t ah = __builtin_bit_cast(bf16x8_t, hi4), al = __builtin_bit_cast(bf16x8_t, lo4);
            const int s = 4 * w8 + i;
            const bf16x8_t bh = *(const LAS bf16x8_t*)(wfr + (s * 64 + lane) * 32), bl = *(const LAS bf16x8_t*)(wfr + (s * 64 + lane) * 32 + 16);
            acc = __builtin_amdgcn_mfma_f32_16x16x32_bf16(ah, bh, acc, 0, 0, 0);
            acc = __builtin_amdgcn_mfma_f32_16x16x32_bf16(ah, bl, acc, 0, 0, 0);
            acc = __builtin_amdgcn_mfma_f32_16x16x32_bf16(al, bh, acc, 0, 0, 0); }
        racc[(it * 8 + w8) * 64 + lane] = acc;
    }
    __syncthreads();
    {
        const int it = w8;
        f32x4 lg = racc[(it * 8) * 64 + lane];
#pragma unroll
        for (int w = 1; w < 8; ++w) lg += racc[(it * 8 + w) * 64 + lane];
        const int e = lane & 15; const float bre = b_router[e];
#pragma unroll
        for (int r = 0; r < 4; ++r) {
            const int tt = blockIdx.x * 128 + 16 * it + 4 * kq + r;
            const float x = lg[r] + bre;
            float m = x; m = fmaxf(m, __shfl_xor(m, 1)); m = fmaxf(m, __shfl_xor(m, 2)); m = fmaxf(m, __shfl_xor(m, 4)); m = fmaxf(m, __shfl_xor(m, 8));
            float p = expf(x - m); float ss = p; ss += __shfl_xor(ss, 1); ss += __shfl_xor(ss, 2); ss += __shfl_xor(ss, 4); ss += __shfl_xor(ss, 8);
            p /= ss;
            const float o1 = __shfl_xor(p, 1), o2 = __shfl_xor(p, 2), o3 = __shfl_xor(p, 3);
            float gs = fmaxf(p + o1, fmaxf(p + o2, p + o3)); gs = fmaxf(gs, __shfl_xor(gs, 1)); gs = fmaxf(gs, __shfl_xor(gs, 2));
            float bv = gs; int bg = (lane >> 2) & 3;
#pragma unroll
            for (int off = 4; off <= 8; off <<= 1) { const float ov = __shfl_xor(bv, off); const int og = __shfl_xor(bg, off); if (ov > bv || (ov == bv && og < bg)) { bv = ov; bg = og; } }
            const int me = lane & 3;
            const int rank = ((o1 > p || (o1 == p && (me ^ 1) < me)) ? 1 : 0) + ((o2 > p || (o2 == p && (me ^ 2) < me)) ? 1 : 0) + ((o3 > p || (o3 == p && (me ^ 3) < me)) ? 1 : 0);
            float v12 = rank < 2 ? p : 0.f; v12 += __shfl_xor(v12, 1); v12 += __shfl_xor(v12, 2);
            if (((lane >> 2) & 3) == bg && rank < 2) { toke[tt * 2 + rank] = e; tokg[tt * 2 + rank] = p / v12; atomicAdd((int*)&hist[e], 1); }
        }
    }
#undef LN1_LOAD
    __syncthreads();
    { const int t2 = F.wave * 64 + fresh_lane(); if (t2 < NE) histg[blockIdx.x * NE + t2] = hist[t2]; }
    __syncthreads();
}
__device__ __forceinline__ void p_route(const Frame& F, const int* toke, int* rt, int* rowtok, int* slot) {
    LAS int* hs = (LAS int*)(F.lds);
    LAS int* part = hs + 256 * 17;
    LAS int* sh = part + 512;
    const int b = blockIdx.x, tid = F.tid, lane = F.lane;
    if (tid < 256) { const int* hp = rt + 16384 + tid * NE;
#pragma unroll
        for (int q = 0; q < 4; ++q) { const int4 c = *(const int4*)(hp + 4 * q); hs[tid * 17 + 4 * q] = c.x; hs[tid * 17 + 4 * q + 1] = c.y; hs[tid * 17 + 4 * q + 2] = c.z; hs[tid * 17 + 4 * q + 3] = c.w; } }
    const int my_e = tid < 256 ? (toke[b * 256 + tid] & (NE - 1)) : -1;
    __syncthreads();
    if (tid < 256) { const int e = tid & 15, p = tid >> 4; int tot = 0, pre = 0;
#pragma unroll
        for (int k = 0; k < 16; ++k) { const int blk = 16 * p + k; const int c = hs[blk * 17 + e]; tot += c; pre += blk < b ? c : 0; }
        part[e * 16 + p] = tot; part[256 + e * 16 + p] = pre; }
    int rank_w = 0;
    if (tid < 256) {
#pragma unroll
        for (int e = 0; e < NE; ++e) { const unsigned long long m = __ballot(my_e == e); if (my_e == e) rank_w = __popcll(m & ((1ull << lane) - 1ull)); if (lane == 0) sh[64 + F.wave * 16 + e] = __popcll(m); } }
    __syncthreads();
    if (tid < 16) { int tot = 0, pre = 0;
#pragma unroll
        for (int p = 0; p < 16; ++p) { tot += part[tid * 16 + p]; pre += part[256 + tid * 16 + p]; }
        sh[tid] = tot; sh[16 + tid] = pre; }
    __syncthreads();
    if (tid == 0) { int off = 0; for (int e = 0; e < NE; ++e) { sh[32 + e] = off; off += (sh[e] + RB - 1) / RB * RB; } sh[48] = off; }
    __syncthreads();
    if (tid < 256) { int r = rank_w; for (int w = 0; w < F.wave; ++w) r += sh[64 + w * 16 + my_e];
        const int pos = sh[32 + my_e] + sh[16 + my_e] + r; rowtok[pos] = b * 128 + (tid >> 1); slot[b * 256 + tid] = pos; }
    if (b < NE) { const int st = sh[32 + b] + sh[b], en = sh[32 + b] + (sh[b] + RB - 1) / RB * RB; for (int r = st + tid; r < en; r += 512) rowtok[r] = T; }
    if (b == 0) { if (tid == 0) rt[48] = sh[48];
        for (int e = 0; e < NE; ++e) { const int st = sh[32 + e] / RB, en = (sh[32 + e] + (sh[e] + RB - 1) / RB * RB) / RB; for (int r = st + tid; r < en; r += 512) rt[64 + r] = e; } }
    __syncthreads();
}
template <bool YB8>
__device__ __forceinline__ void p_ln2(const Frame& F, const bf16* H1, const bf16* YB, const int* slot, const float* tokg, const float* g, const float* bb, bf16* H0, float* outf,
                                      const float* w_in_next, const float* bf_next, float* logf) {
    const int lane = F.lane;
    LAS float* wfl = (LAS float*)F.lds;
    if (!outf) { for (int k = F.tid; k < D; k += 512) { const f32x4 w = *(const GAS f32x4*)(w_in_next + (size_t)k * NPROJ + NZ); wfl[k] = w.x; wfl[D + k] = w.y; wfl[2 * D + k] = w.z; wfl[3 * D + k] = w.w; }
        __syncthreads(); }
    const int nrow = (T - F.gw + F.NGW - 1) / F.NGW;
    int sl0 = 0, sl1 = 0; float gg0 = 0.f, gg1 = 0.f;
    if (lane < nrow) { const int tk = F.gw + lane * F.NGW; sl0 = slot[tk * 2]; sl1 = slot[tk * 2 + 1]; gg0 = tokg[tk * 2]; gg1 = tokg[tk * 2 + 1]; }
    v4u rh0, rh1, ra0, ra1, rb0, rb1;
#define LN2_LOAD(k_) do { const int tt_ = F.gw + (k_) * F.NGW; const int s0_ = __shfl(sl0, (k_)), s1_ = __shfl(sl1, (k_)); \
        const bf16* hp_ = H1 + (size_t)tt_ * D + lane * 16; rh0 = *(const GAS v4u*)hp_; rh1 = *(const GAS v4u*)(hp_ + 8); \
        if (YB8) { ra0 = *(const GAS v4u*)((const unsigned char*)YB + (size_t)s0_ * D + lane * 16); rb0 = *(const GAS v4u*)((const unsigned char*)YB + (size_t)s1_ * D + lane * 16); } \
        else { const bf16* p0_ = YB + (size_t)s0_ * D + lane * 16; const bf16* p1_ = YB + (size_t)s1_ * D + lane * 16; \
               ra0 = *(const GAS v4u*)p0_; ra1 = *(const GAS v4u*)(p0_ + 8); rb0 = *(const GAS v4u*)p1_; rb1 = *(const GAS v4u*)(p1_ + 8); } } while (0)
    if (nrow > 0) LN2_LOAD(0);
    for (int k = 0; k < nrow; ++k) {
        asm volatile("" ::: "memory");
        const int t = F.gw + k * F.NGW; const float g0 = __shfl(gg0, k), g1 = __shfl(gg1, k);
        float v[16]; float s = 0.f;
        { float a[16], y0[16], y1[16];
          unpack8(rh0, a); unpack8(rh1, a + 8);
          if (YB8) { typedef float f32x2_ __attribute__((ext_vector_type(2)));
#pragma unroll
              for (int q = 0; q < 4; ++q) { const int wa = (int)(q == 0 ? ra0.x : q == 1 ? ra0.y : q == 2 ? ra0.z : ra0.w), wb = (int)(q == 0 ? rb0.x : q == 1 ? rb0.y : q == 2 ? rb0.z : rb0.w);
                  const f32x2_ a0 = __builtin_amdgcn_cvt_pk_f32_fp8(wa, false), a1 = __builtin_amdgcn_cvt_pk_f32_fp8(wa, true), b0 = __builtin_amdgcn_cvt_pk_f32_fp8(wb, false), b1 = __builtin_amdgcn_cvt_pk_f32_fp8(wb, true);
                  y0[4 * q] = a0.x * 0.125f; y0[4 * q + 1] = a0.y * 0.125f; y0[4 * q + 2] = a1.x * 0.125f; y0[4 * q + 3] = a1.y * 0.125f;
                  y1[4 * q] = b0.x * 0.125f; y1[4 * q + 1] = b0.y * 0.125f; y1[4 * q + 2] = b1.x * 0.125f; y1[4 * q + 3] = b1.y * 0.125f; } }
          else { unpack8(ra0, y0); unpack8(ra1, y0 + 8); unpack8(rb0, y1); unpack8(rb1, y1 + 8); }
          if (k + 1 < nrow) LN2_LOAD(k + 1);
#pragma unroll
          for (int j = 0; j < 16; ++j) { v[j] = ALPHA * a[j] + (g0 * y0[j] + g1 * y1[j]); s += v[j]; } }
        const float mu = wave_sum(s) * (1.f / D); float q = 0.f;
#pragma unroll
        for (int j = 0; j < 16; ++j) { v[j] -= mu; q += v[j] * v[j]; }
        const float rstd = rsqrtf(wave_sum(q) * (1.f / D) + LN_EPS);
        { const float* gp = g + lane * 16; const float* bp = bb + lane * 16; asm volatile("" : "+v"(gp), "+v"(bp));
#pragma unroll
          for (int j4 = 0; j4 < 4; ++j4) { const f32x4 g4 = *(const GAS f32x4*)(gp + 4 * j4), b4 = *(const GAS f32x4*)(bp + 4 * j4);
#pragma unroll
            for (int jj = 0; jj < 4; ++jj) v[4 * j4 + jj] = v[4 * j4 + jj] * rstd * g4[jj] + b4[jj]; } }
        if (outf) { GAS f32x4* o = (GAS f32x4*)(outf + (size_t)t * D + lane * 16);
#pragma unroll
            for (int j = 0; j < 4; ++j) __builtin_nontemporal_store((f32x4){v[4 * j], v[4 * j + 1], v[4 * j + 2], v[4 * j + 3]}, (f32x4*)(o + j)); }
        else { *(GAS v4u*)(H0 + (size_t)t * D + lane * 16) = pack8(v); *(GAS v4u*)(H0 + (size_t)t * D + lane * 16 + 8) = pack8(v + 8);
            float acc[4] = {0.f, 0.f, 0.f, 0.f};
#pragma unroll
            for (int q = 0; q < 4; ++q)
#pragma unroll
                for (int j4 = 0; j4 < 4; ++j4) { const f32x4 w = *(const LAS f32x4*)(wfl + q * D + lane * 16 + 4 * j4); acc[q] += v[4 * j4] * w.x + v[4 * j4 + 1] * w.y + v[4 * j4 + 2] * w.z + v[4 * j4 + 3] * w.w; }
#pragma unroll
            for (int q = 0; q < 4; ++q) acc[q] = wave_sum(acc[q]);
            if (lane < 4) { const float z = (lane == 0 ? acc[0] : lane == 1 ? acc[1] : lane == 2 ? acc[2] : acc[3]) + bf_next[lane];
                logf[(size_t)t * 4 + lane] = fminf(z, 0.f) - log1pf(expf(-fabsf(z))); } }
    }
#undef LN2_LOAD
    __syncthreads();
}
__device__ __forceinline__ void p_attn(const Frame& F, int vcu, const bf16* Z, const float* logf, bf16* OF, bf16* OP, float* ML, const float* kmax, int* dqc, const float* kmaxd) {
    char* shm = (char*)F.lds;
#ifndef DUPMASK
#define DUPMASK 0u
#endif
#pragma nounroll
    for (int rf_ = 0; rf_ < (((DUPMASK >> 11) & 1u) ? 2 : 1); ++rf_) {
        const int bh = vcu >> 3, sidx = vcu & 7, b = bh >> 2, h = bh & 3;
        att::fox_bias(b, h, 256 * (16 - sidx), logf, shm, F.tid);
        const float bk2 = kmax[(b * HD_FOX + h) * 2] + kmax[(b * HD_FOX + h) * 2 + 1];
        att::fox_unit(b, h, 15 - sidx, Z, OF, shm, F.tid, bk2);
        att::fox_unit(b, h, sidx, Z, OF, shm, F.tid, bk2);
    }
    {
        att::u32x4 kv[12], qv[4]; att::bf16x8 qr[4];
        const int xcd_ = vcu >> 5;
        LAS int* dq = (LAS int*)(F.lds + att::L_WSF);
        const bool t0 = F.tid == 0;
        if (t0) { dq[0] = atomicAdd(dqc, 1); dq[1] = atomicAdd(dqc, 1); }
        __syncthreads();
        int ucur = dq[0], unxt = dq[1];
#define DIL_UNIT(q_) ((xcd_ + 8 * ((q_) / 48)) * 48 + (q_) % 48)
        att::DilU cu = att::dil_decode(DIL_UNIT(ucur < 576 ? ucur : 0)), nu = cu;
        if (ucur < 576) att::dil_issue(cu, Z, F.tid, kv, qv);
        for (int i = 0; ucur < 576; ++i) {
            att::dil_commit(shm, F.tid, kv, qv);
            asm volatile("s_waitcnt lgkmcnt(0)\n\ts_barrier" ::: "memory");
            int ufut = 0; if (t0) ufut = atomicAdd(dqc, 1);
            att::dil_qfrag(shm, F.tid, qr);
            if (unxt < 576) { nu = att::dil_decode(DIL_UNIT(unxt)); att::dil_issue(nu, Z, F.tid, kv, qv); }
            att::dil_compute(cu, qr, OP, ML, shm, F.tid, kmaxd[cu.b * HD_DIL + cu.h]);
            if (t0) dq[2 + (i & 1)] = ufut;
            asm volatile("s_waitcnt lgkmcnt(0)\n\ts_barrier" ::: "memory");
            cu = nu; ucur = unxt; unxt = dq[2 + (i & 1)];
        }
#undef DIL_UNIT
    }
}

#ifndef GU_ALIGN
#define GU_ALIGN true
#endif
#ifndef IP_ALIGN
#define IP_ALIGN true
#endif
enum { PH_PRO = 0, PH_LOGF = 1, PH_INPROJ, PH_ATTN, PH_MERGE, PH_OUTPROJ, PH_LN1, PH_ROUTE, PH_GATEUP, PH_DOWN, PH_LN2, PH_PER_LAYER = 10, PH_TOTAL = 1 + 2 * PH_PER_LAYER };

__global__ void __launch_bounds__(NWAVES * 64, 2) mk_fwd(Args args) {
    extern __shared__ __attribute__((aligned(16))) unsigned char lds[];
    LAS unsigned char* const ldsb = (LAS unsigned char*)lds;
    typedef const __attribute__((address_space(4))) Args* KArgs;
    const int wave_s = __builtin_amdgcn_readfirstlane(threadIdx.x >> 6);
    const int bx = blockIdx.x; const int vcu = (gridDim.x % 8 == 0) ? (bx % 8) * ((int)gridDim.x / 8) + bx / 8 : bx;
#define MKF() KArgs ap = (KArgs)__builtin_amdgcn_kernarg_segment_ptr(); asm volatile("" : "+s"(ap)); Frame F; { F.lds = ldsb; F.lane = fresh_lane(); F.wave = wave_s; F.tid = wave_s * 64 + F.lane; \
                         F.G = gridDim.x; F.gw = vcu * NWAVES + F.wave; F.NGW = F.G * NWAVES; }
#define W_(off) (ap->ws + (off))
#define P_Z ((bf16*)W_(WS_Z))
#define P_OP ((bf16*)W_(WS_OP))
#define P_H0 ((bf16*)W_(WS_H0))
#define P_H1 ((bf16*)W_(WS_H1))
#define P_WINT ((bf16*)W_(WS_WIO))
#define P_WOUTT ((bf16*)W_(WS_WIO + 12 * MiB))
#define P_WGT ((bf16*)((unsigned char*)ap->out + OUT_WG))
#define P_WUT ((bf16*)((unsigned char*)ap->out + OUT_WU))
#define P_WDT ((bf16*)((unsigned char*)ap->out + OUT_WD))
#define P_WG8L(l_) ((unsigned char*)ap->out + (size_t)(l_) * OUT_WL + OUT_WG8)
#define P_WU8L(l_) ((unsigned char*)ap->out + (size_t)(l_) * OUT_WL + OUT_WU8)
#define P_WD8L(l_) ((unsigned char*)ap->out + (size_t)(l_) * OUT_WL + OUT_WD8)
#define P_WG8 P_WG8L(0)
#define P_WU8 P_WU8L(0)
#define P_WD8 P_WD8L(0)
#define P_H1Q ((unsigned char*)W_(WS_H1Q))
#define CONV_PULL(n_) conv_pull(F, ap->in[10] + (size_t)NE * D * D, ap->in[11] + (size_t)NE * D * D, ap->in[12] + (size_t)NE * D * D, P_WG8L(1), (int*)P_SM(SM_CTL) + CW_CQ, (n_))
#ifndef CQ_GU
#define CQ_GU 5
#endif
#ifndef CQ_DN
#define CQ_DN 5
#endif
#define CONV_EXPERTS(l_) do { const size_t eo_ = (size_t)(l_) * NE * D * D; \
        if (((l_) == 0) ? MOE_FP8_L0 : MOE_FP8_L1) { conv_expert_mat8(F, ap->in[10] + eo_, P_WG8); conv_expert_mat8(F, ap->in[11] + eo_, P_WU8); conv_expert_mat8(F, ap->in[12] + eo_, P_WD8); } \
        else { conv_expert_mat(F, ap->in[10] + eo_, P_WGT); conv_expert_mat(F, ap->in[11] + eo_, P_WUT); conv_expert_mat(F, ap->in[12] + eo_, P_WDT); } } while (0)
#define P_SM(off) (W_(WS_SM + (off)))
#define P_LOGF ((float*)P_SM(SM_LOGF))
#define P_TOKE ((int*)P_SM(SM_TOKE))
#define P_TOKG ((float*)P_SM(SM_TOKG))
#define P_SLOT ((int*)P_SM(SM_SLOT))
#define P_ROWTOK ((int*)P_SM(SM_ROWTOK))
#define P_RT ((int*)P_SM(SM_RT))
#define P_WF ((float*)P_SM(SM_WF))
#define P_ML ((float*)P_SM(SM_ML))
#define P_OF ((bf16*)P_SM(SM_OF))
    volatile LAS unsigned* MISC = (volatile LAS unsigned*)(ldsb + MISC_OFF);
    { const int l_ = fresh_lane(); if (wave_s == 0) MISC[l_] = 0u; }
    __syncthreads();
    unsigned* ctl; { KArgs ap = (KArgs)__builtin_amdgcn_kernarg_segment_ptr(); ctl = (unsigned*)P_SM(SM_CTL); }
    const bool multi = (args.ph_hi - args.ph_lo) > 1;
    XcdBarrier bar; bar.bar = ctl + CW_BAR; bar.x = 0; bar.st = nullptr;
#define T0_() (wave_s == 0 && fresh_lane() == 0)
    if (multi) bar = xcd_barrier_post(ctl + CW_BAR, MISC + 8, T0_());
    const int lo = args.ph_lo, hi = args.ph_hi;
#ifndef PHMASK
#define PHMASK 0xFFFFFFFFu
#endif
#define IN(k) (((PHMASK >> ((k) > 10 ? (k) - 10 : (k))) & 1u) && lo <= (k) && (k) < hi)
#define REP(k) for (int rep_ = 0; rep_ < (((DUPMASK >> (k)) & 1u) ? 2 : 1); ++rep_)
#define SEAM(k) do { if (IN(k) && IN((k) + 1)) { xcd_barrier(bar, T0_()); if ((DUPMASK >> 13) & 1u) xcd_barrier(bar, T0_()); } } while (0)
    if (IN(PH_PRO)) REP(PH_PRO) { MKF();
        p_prologue(F, ap->in[0], ap->in[1], ap->in[5], P_WINT, P_WOUTT, P_H0, P_H1, ap->in[2], P_LOGF);
        CONV_EXPERTS(0);
    } SEAM(PH_PRO);
    auto layer = [&](auto lc) __attribute__((always_inline)) {
        constexpr int l = decltype(lc)::value; constexpr int base = l * PH_PER_LAYER; constexpr bool F8 = (l == 0) ? MOE_FP8_L0 : MOE_FP8_L1;
        if (IN(base + PH_INPROJ)) REP(PH_INPROJ) { MKF();
            pg8::Gemm g{P_H0, P_WINT + (size_t)l * NZ * D, nullptr, nullptr};
            pg8::TileOrder So; So.init(T / 256, NZ / 256, F.G, bx);
            pg8::EpiInproj E{P_Z, (unsigned*)P_SM(SM_CTL) + CW_KMAX + l * 64, (unsigned*)P_SM(SM_CTL) + CW_KMAXD + l * 96};
            pg8::gemm_phase<pg8::EpiInproj, 128L * D * 2, 256, false, false, false, IP_ALIGN>(F.lds, g, So, E, F.tid);
        } SEAM(base + PH_INPROJ);
        if (IN(base + PH_ATTN)) REP(PH_ATTN) { MKF(); p_attn(F, vcu, P_Z, P_LOGF, P_OF, P_OP, P_ML, (const float*)((unsigned*)P_SM(SM_CTL) + CW_KMAX + l * 64), (int*)P_SM(SM_CTL) + CW_DQ + (l * 8 + (vcu >> 5)) * 64, (const float*)((unsigned*)P_SM(SM_CTL) + CW_KMAXD + l * 96)); } SEAM(base + PH_ATTN);
        if (IN(base + PH_MERGE)) REP(PH_MERGE) { MKF(); p_merge(F, P_OP, P_ML, P_OF, ap->in[3] + l * 768, ap->in[4] + l * 256, P_H1  ); } SEAM(base + PH_MERGE);
        if (IN(base + PH_OUTPROJ)) REP(PH_OUTPROJ) { MKF();
            pg8::Gemm g{P_H1  , P_WOUTT + (size_t)l * D * D, nullptr, nullptr};
            pg8::TileOrder So; So.init(T / 256, D / 256, F.G, bx);
            pg8::EpiPlain E{P_Z  , D, 1.f};
            pg8::gemm_phase<pg8::EpiPlain, 128L * D * 2, 256, false, false>(F.lds, g, So, E, F.tid);
        } SEAM(base + PH_OUTPROJ);
        if (IN(base + PH_LN1)) REP(PH_LN1) { MKF(); p_ln1(F, P_H0, P_Z  , ap->in[6] + l * D, ap->in[7] + l * D, ap->in[8], ap->in[9], P_H1, P_TOKE, P_TOKG, P_RT + 16384, F8 ? P_H1Q : nullptr); } SEAM(base + PH_LN1);
        if (IN(base + PH_ROUTE)) REP(PH_ROUTE) { MKF(); p_route(F, P_TOKE, P_RT, P_ROWTOK, P_SLOT); } SEAM(base + PH_ROUTE);
        if (IN(base + PH_GATEUP)) REP(PH_GATEUP) { MKF();
            const int nblk = __builtin_amdgcn_readfirstlane(P_RT[48]) / RB;
            pg8::TileOrder So; So.init(nblk, 8, F.G, bx);
            if constexpr (F8) { pg8::Gemm g{P_H1Q, P_WG8L(l), P_ROWTOK, P_RT + 64}; pg8::EpiSwiglu8 E{(unsigned char*)P_Z  };
                pg8::gemm_phase<pg8::EpiSwiglu8, (long)(OUT_WU8 - OUT_WG8), 128, true, true, true, GU_ALIGN>(F.lds, g, So, E, F.tid);
                if constexpr (l == 0 && MOE_FP8_L1) { asm volatile("" ::: "memory"); const int nwg = (__builtin_amdgcn_readfirstlane(P_RT[48]) / RB) * 8, mine = nwg > bx ? (nwg - bx + F.G - 1) / F.G : 0, mx = (nwg + F.G - 1) / F.G;
                    if (mx > mine) CONV_PULL((mx - mine) * CQ_GU); } }
            else { pg8::Gemm g{P_H1, P_WGT, P_ROWTOK, P_RT + 64}; pg8::EpiSwiglu E{P_Z  };
                pg8::gemm_phase<pg8::EpiSwiglu, (long)(OUT_WU - OUT_WG), 128, true, true>(F.lds, g, So, E, F.tid); }
        } SEAM(base + PH_GATEUP);
        if (IN(base + PH_DOWN)) REP(PH_DOWN) { MKF();
            const int nblk = __builtin_amdgcn_readfirstlane(P_RT[48]) / RB;
            pg8::TileOrder So; So.init(nblk, 4, F.G, bx);
            if constexpr (F8) { pg8::Gemm g{P_Z  , P_WD8L(l), nullptr, P_RT + 64}; pg8::EpiPlain8 E{(unsigned char*)P_OP  , 8.f / 32.f};
                pg8::gemm_phase<pg8::EpiPlain8, 128L * D, 256, false, true, true>(F.lds, g, So, E, F.tid);
                if constexpr (l == 0 && MOE_FP8_L1) { asm volatile("" ::: "memory"); const int nwg = (__builtin_amdgcn_readfirstlane(P_RT[48]) / RB) * 4, mine = nwg > bx ? (nwg - bx + F.G - 1) / F.G : 0, mx = (nwg + F.G - 1) / F.G;
                    if (mx > mine) CONV_PULL((mx - mine) * CQ_DN); } }
            else { pg8::Gemm g{P_Z  , P_WDT, nullptr, P_RT + 64}; pg8::EpiPlain E{P_OP  , D, 1.f};
                pg8::gemm_phase<pg8::EpiPlain, 128L * D * 2, 256, false, true>(F.lds, g, So, E, F.tid); }
        } SEAM(base + PH_DOWN);
        if (IN(base + PH_LN2)) REP(PH_LN2) { MKF();
            p_ln2<F8>(F, P_H1, P_OP  , P_SLOT, P_TOKG, ap->in[13] + l * D, ap->in[14] + l * D, P_H0, l == DEPTH - 1 ? ap->out : nullptr,
                  ap->in[1] + (size_t)(l + 1 < DEPTH ? l + 1 : 0) * D * NPROJ, ap->in[2] + (l + 1 < DEPTH ? l + 1 : 0) * 4, P_LOGF);
            if constexpr (l + 1 < DEPTH) { if constexpr (MOE_FP8_L1) CONV_PULL(0x7fffffff); else CONV_EXPERTS(l + 1); }
        } SEAM(base + PH_LN2);
    };
    layer(std::integral_constant<int, 0>{});
    layer(std::integral_constant<int, 1>{});
    if (lo == 100) { MKF(); CONV_PULL(0x7fffffff); }
#undef IN
#undef SEAM
}


extern "C" void kernel_launch(void* const* d_in, const int* in_sizes, int n_in, void* d_out, int out_size, void* d_ws, size_t ws_size, hipStream_t stream) {
    static int grid = 0;
    if (grid == 0) {
        if (n_in != 15 || out_size != T * D || ws_size < WS_END) { fprintf(stderr, "kernel_launch: unexpected shapes / workspace (%d inputs, out %d, ws %zu < %zu)\n", n_in, out_size, ws_size, (size_t)WS_END); grid = -1; return; }
        int dev = 0, cus = 0;
        if (hipGetDevice(&dev) != hipSuccess || hipDeviceGetAttribute(&cus, hipDeviceAttributeMultiprocessorCount, dev) != hipSuccess) { grid = -1; return; }
        if (hipFuncSetAttribute((const void*)mk_fwd, hipFuncAttributeMaxDynamicSharedMemorySize, LDS_BYTES) != hipSuccess) { grid = -1; return; }
        int per_cu = 0; (void)hipOccupancyMaxActiveBlocksPerMultiprocessor(&per_cu, (const void*)mk_fwd, NWAVES * 64, LDS_BYTES); (void)hipGetLastError();
        if (cus != 256 || per_cu < 1) { fprintf(stderr, "kernel_launch: needs 256 CUs with one resident workgroup each (cus %d, per_cu %d)\n", cus, per_cu); grid = -1; return; }
        grid = 256;
    }
    if (grid < 0) return;
    unsigned char* sm = (unsigned char*)d_ws + WS_SM;
    (void)hipMemsetAsync(sm + SM_CTL, 0, 1 * MiB, stream);
    Args a{};
    for (int i = 0; i < 15; ++i) a.in[i] = (const float*)d_in[i];
    a.out = (float*)d_out; a.ws = (unsigned char*)d_ws;
#if MK_DEBUG
    debug_forward(a, d_in, d_out, d_ws, stream, grid);
#else
    a.ph_lo = 0; a.ph_hi = PH_TOTAL; a.li = 0;
    hipLaunchKernelGGL(mk_fwd, dim3(grid), dim3(NWAVES * 64), LDS_BYTES, stream, a);
#endif
}
```

```cpp
#include <hip/hip_runtime.h>
#include <stdint.h>
#include <math.h>
#include <cstdio>

#ifndef MK_DEBUG
#define MK_DEBUG 0
#endif
#ifndef NAIVE_MASK
#define NAIVE_MASK 0
#endif

typedef unsigned short bf16;
constexpr int NB = 8, S = 4096, D = 1024, T = NB * S, DEPTH = 2;
constexpr int NPROJ = 3076, NZ = 3072;
constexpr int HD_DIL = 12, HD_FOX = 4;
constexpr int NE = 16;
constexpr int RB = 256;
constexpr int ROWS_MAX = 2 * T + NE * RB;
constexpr int NBLK_MAX = ROWS_MAX / RB;
constexpr float ALPHA = 1.41421356237f;
constexpr float LN_EPS = 1e-5f, RMS_EPS = 1e-6f;
constexpr float LOG2E = 1.4426950408889634f;
constexpr float C2 = 0.125f * LOG2E;
constexpr size_t RQA = 0, RKA = (size_t)T * 768, RVA = (size_t)T * 1536, RQF = (size_t)T * 2304, RKF = (size_t)T * 2560, RVF = (size_t)T * 2816;

__device__ __forceinline__ float bf2f(bf16 v) { return __uint_as_float(((unsigned)v) << 16); }
__device__ __forceinline__ bf16 f2bf(float f) { unsigned u = __float_as_uint(f); return (bf16)((u + 0x7fffu + ((u >> 16) & 1u)) >> 16); }
typedef float f32x2_cv __attribute__((ext_vector_type(2))); typedef __bf16 bf16x2_cv __attribute__((ext_vector_type(2)));
__device__ __forceinline__ unsigned pk2(float lo, float hi) { f32x2_cv v = {lo, hi}; bf16x2_cv b = __builtin_convertvector(v, bf16x2_cv); return __builtin_bit_cast(unsigned, b); }

constexpr size_t MiB = 1u << 20;
constexpr size_t WS_Z = 0;
constexpr size_t WS_OP = 192 * MiB;
constexpr size_t WS_H0 = 336 * MiB;
constexpr size_t WS_H1 = 401 * MiB;
constexpr size_t WS_WIO = 466 * MiB;
constexpr size_t WS_SM = 482 * MiB;
constexpr size_t SM_CTL = 0;
constexpr size_t SM_LOGF = 1 * MiB;
constexpr size_t SM_CUM = 2 * MiB;
constexpr size_t SM_TOKE = 3 * MiB;
constexpr size_t SM_TOKG = 4 * MiB;
constexpr size_t SM_SLOT = 5 * MiB;
constexpr size_t SM_ROWTOK = 6 * MiB;
constexpr size_t SM_RT = 7 * MiB;
constexpr size_t SM_WF = 8 * MiB;
constexpr size_t SM_ML = 9 * MiB;
constexpr size_t SM_OF = 18 * MiB;
constexpr size_t WS_END = WS_SM + 34 * MiB;
constexpr size_t OUT_WG = 0, OUT_WU = 32 * MiB, OUT_WD = 64 * MiB;
constexpr size_t OUT_WG8 = 0, OUT_WU8 = 16 * MiB, OUT_WD8 = 32 * MiB, OUT_WL = 48 * MiB;
constexpr size_t WS_H1Q = WS_Z + 128 * MiB;
#ifndef MOE_FP8_L0
#define MOE_FP8_L0 1
#endif
#ifndef MOE_FP8_L1
#define MOE_FP8_L1 1
#endif
constexpr int CW_BAR = 4096;
constexpr int CW_CQ = 20480;
constexpr int CW_DQ = 16384;
constexpr int CW_KMAXD = 8320;
constexpr int CW_KMAX = 8192;

namespace pg8 {
#define PG8_LAS __attribute__((address_space(3)))
typedef unsigned short bf16_t;
typedef short bf16x8 __attribute__((ext_vector_type(8)));
typedef float f32x4 __attribute__((ext_vector_type(4)));
typedef unsigned u32x4 __attribute__((ext_vector_type(4)));
constexpr int BM = 256, BK = 64, HALF = 128, HTB = HALF * BK * 2, STAGE_BYTES = 8 * HTB, NXCD = 8, WGM = 8;
constexpr int GT_MAX = 10;
constexpr int GTAB_OFF = STAGE_BYTES;
constexpr int ETAB_OFF = GTAB_OFF + GT_MAX * 1024;

__host__ __device__ __forceinline__ int lds_byte(int r, int c) { const int st = (r >> 4) * 2 + (c >> 5), rr = r & 15, cc = c & 31, ob = rr * 64 + cc * 2; return st * 1024 + (ob ^ (((ob >> 9) & 1) << 5)); }
__host__ __device__ __forceinline__ void stage_rc(int b, int& R, int& C) { const int st = b / 1024, sb = b % 1024, swz = sb ^ (((sb >> 9) & 1) << 5); R = (st >> 1) * 16 + swz / 64; C = (st & 1) * 32 + (swz % 64) / 2; }
__host__ __device__ __forceinline__ int perm32(int rho) { const int n = rho >> 4, i = rho & 15; return 8 * (i >> 2) + 4 * n + (i & 3); }

struct Unit { int pm, pn; };
struct TileOrder {
    int nM, nN, nwg, G, c;
    __device__ void init(int nM_, int nN_, int G_, int c_) { nM = nM_; nN = nN_; nwg = nM * nN; G = G_; c = c_; }
    __device__ bool next(int i, Unit& u) const {
        const long L = (long)i * G + c; if (L >= nwg) return false;
        int wgid = (int)L; { const int q = nwg / NXCD, r = nwg % NXCD, xcd = wgid % NXCD, off = wgid / NXCD; wgid = (xcd < r ? xcd * (q + 1) : r * (q + 1) + (xcd - r) * q) + off; }
        const int nig = WGM * nN, gid = wgid / nig, fm = gid * WGM, gsz = (nM - fm) < WGM ? (nM - fm) : WGM;
        u.pm = fm + ((wgid % nig) % gsz); u.pn = (wgid % nig) / gsz; return true;
    }
};
struct Gemm { const void* A; const void* B0; const int* gather; const int* blk_e; };

__device__ __forceinline__ float rows4_sum(float v) {
    auto a = __builtin_amdgcn_permlane16_swap(__float_as_uint(v), __float_as_uint(v), false, false); v = __uint_as_float(a[0]) + __uint_as_float(a[1]);
    auto b = __builtin_amdgcn_permlane32_swap(__float_as_uint(v), __float_as_uint(v), false, false); return __uint_as_float(b[0]) + __uint_as_float(b[1]);
}
template <int CTRL> __device__ __forceinline__ float dppf(float v) { return __int_as_float(__builtin_amdgcn_update_dpp(0, __float_as_int(v), CTRL, 0xF, 0xF, false)); }
__device__ __forceinline__ float row16_max(float v) { v = fmaxf(v, dppf<0xB1>(v)); v = fmaxf(v, dppf<0x4E>(v)); v = fmaxf(v, dppf<0x141>(v)); return fmaxf(v, dppf<0x140>(v)); }
__device__ __forceinline__ unsigned cvt_pk_bf16(float lo, float hi) { unsigned r; asm volatile("v_cvt_pk_bf16_f32 %0, %1, %2" : "=v"(r) : "v"(lo), "v"(hi)); return r; }

#ifndef WT_STORES
#define WT_STORES 0
#endif
__device__ __forceinline__ void st16(void* p, u32x4 v) {
#if WT_STORES
    asm volatile("global_store_dwordx4 %0, %1, off sc1\n\ts_nop 1" :: "v"(p), "v"(v) : "memory");
#else
    *(u32x4*)p = v;
#endif
}
typedef unsigned u32x2_st __attribute__((ext_vector_type(2)));
__device__ __forceinline__ void st8(void* p, u32x2_st v) {
#if WT_STORES
    asm volatile("global_store_dwordx2 %0, %1, off sc1\n\ts_nop 1" :: "v"(p), "v"(v) : "memory");
#else
    *(u32x2_st*)p = v;
#endif
}
struct EpiPlain {
    bf16_t* O; int ldc; float sc;
    __device__ __forceinline__ void operator()(const f32x4 (&acc)[2][2][4][2], const Unit& u, int wr, int wc, int fr, int fq) const {
        const int row0 = u.pm * BM + wr * 64 + fr; const int col0 = u.pn * BM + wc * 32 + 8 * fq;
#pragma unroll
        for (int ai = 0; ai < 2; ++ai)
#pragma unroll
            for (int m = 0; m < 4; ++m) { bf16_t* rowp = O + (size_t)(row0 + ai * HALF + m * 16) * ldc + col0;
#pragma unroll
                for (int bj = 0; bj < 2; ++bj) { const f32x4 v0 = acc[ai][bj][m][0], v1 = acc[ai][bj][m][1];
                    u32x4 w; w.x = cvt_pk_bf16(v0[0], v0[1]); w.y = cvt_pk_bf16(v0[2], v0[3]); w.z = cvt_pk_bf16(v1[0], v1[1]); w.w = cvt_pk_bf16(v1[2], v1[3]);
                    st16(rowp + bj * HALF, w); } }
    }
};
struct EpiPlain8 {
    unsigned char* O; float sc;
    __device__ __forceinline__ void operator()(const f32x4 (&acc)[2][2][4][2], const Unit& u, int wr, int wc, int fr, int fq) const {
        const int row0 = u.pm * BM + wr * 64 + fr; const int col0 = u.pn * BM + wc * 32 + 8 * fq;
#pragma unroll
        for (int ai = 0; ai < 2; ++ai)
#pragma unroll
            for (int m = 0; m < 4; ++m) { unsigned char* rowp = O + (size_t)(row0 + ai * HALF + m * 16) * 1024 + col0;
#pragma unroll
                for (int bj = 0; bj < 2; ++bj) { const f32x4 v0 = acc[ai][bj][m][0] * sc, v1 = acc[ai][bj][m][1] * sc;
                    int w0 = 0, w1 = 0;
                    w0 = __builtin_amdgcn_cvt_pk_fp8_f32(v0[0], v0[1], w0, false); w0 = __builtin_amdgcn_cvt_pk_fp8_f32(v0[2], v0[3], w0, true);
                    w1 = __builtin_amdgcn_cvt_pk_fp8_f32(v1[0], v1[1], w1, false); w1 = __builtin_amdgcn_cvt_pk_fp8_f32(v1[2], v1[3], w1, true);
                    st8(rowp + bj * HALF, (u32x2_st){(unsigned)w0, (unsigned)w1}); } }
    }
};
struct EpiSwiglu {
    bf16_t* O;
    __device__ __forceinline__ void operator()(const f32x4 (&acc)[2][2][4][2], const Unit& u, int wr, int wc, int fr, int fq) const {
        const int row0 = u.pm * BM + wr * 64 + fr; const int col0 = u.pn * HALF + wc * 32 + 8 * fq;
#pragma unroll
        for (int ai = 0; ai < 2; ++ai)
#pragma unroll
            for (int m = 0; m < 4; ++m) { bf16_t* rowp = O + (size_t)(row0 + ai * HALF + m * 16) * 1024 + col0;
                float r[8];
#pragma unroll
                for (int n = 0; n < 2; ++n)
#pragma unroll
                    for (int j = 0; j < 4; ++j) { const float g = acc[ai][0][m][n][j], up = acc[ai][1][m][n][j];
                        r[n * 4 + j] = g * __builtin_amdgcn_rcpf(1.f + __builtin_amdgcn_exp2f(-g * LOG2E)) * up; }
                u32x4 w; w.x = cvt_pk_bf16(r[0], r[1]); w.y = cvt_pk_bf16(r[2], r[3]); w.z = cvt_pk_bf16(r[4], r[5]); w.w = cvt_pk_bf16(r[6], r[7]);
                st16(rowp, w); __builtin_amdgcn_sched_barrier(0); }
    }
};
struct EpiSwiglu8 {
    unsigned char* O;
    __device__ __forceinline__ void operator()(const f32x4 (&acc)[2][2][4][2], const Unit& u, int wr, int wc, int fr, int fq) const {
        typedef unsigned u32x2 __attribute__((ext_vector_type(2)));
        const int row0 = u.pm * BM + wr * 64 + fr; const int col0 = u.pn * HALF + wc * 32 + 8 * fq;
#pragma unroll
        for (int ai = 0; ai < 2; ++ai)
#pragma unroll
            for (int m = 0; m < 4; ++m) { unsigned char* rowp = O + (size_t)(row0 + ai * HALF + m * 16) * 1024 + col0;
                float r[8];
#pragma unroll
                for (int n = 0; n < 2; ++n)
#pragma unroll
                    for (int jp = 0; jp < 2; ++jp) { typedef float f32x2_ __attribute__((ext_vector_type(2)));
                        const f32x2_ g2 = {acc[ai][0][m][n][2 * jp], acc[ai][0][m][n][2 * jp + 1]}, u2 = {acc[ai][1][m][n][2 * jp], acc[ai][1][m][n][2 * jp + 1]};
                        const f32x2_ x2 = g2 * (-LOG2E / 32.f);
                        const f32x2_ e2 = {__builtin_amdgcn_exp2f(x2.x), __builtin_amdgcn_exp2f(x2.y)};
                        const f32x2_ d2 = e2 * 1024.f + 1024.f;
                        const f32x2_ q2 = {__builtin_amdgcn_rcpf(d2.x), __builtin_amdgcn_rcpf(d2.y)};
                        const f32x2_ o2 = (g2 * u2) * q2;
                        r[n * 4 + 2 * jp] = o2.x; r[n * 4 + 2 * jp + 1] = o2.y; }
                int w0 = 0, w1 = 0;
                w0 = __builtin_amdgcn_cvt_pk_fp8_f32(r[0], r[1], w0, false); w0 = __builtin_amdgcn_cvt_pk_fp8_f32(r[2], r[3], w0, true);
                w1 = __builtin_amdgcn_cvt_pk_fp8_f32(r[4], r[5], w1, false); w1 = __builtin_amdgcn_cvt_pk_fp8_f32(r[6], r[7], w1, true);
                st8(rowp, (u32x2_st){(unsigned)w0, (unsigned)w1}); __builtin_amdgcn_sched_barrier(0); }
    }
};
struct EpiInproj {
    bf16_t* Z; unsigned* kmax; unsigned* kmaxd;
    __device__ __forceinline__ void operator()(const f32x4 (&acc)[2][2][4][2], const Unit& u, int wr, int wc, int fr, int fq) const {
        const int row0 = u.pm * BM + wr * 64 + fr;
        const int bb = (u.pm * BM) / S;
        if (u.pn < 6) {
            typedef float f32x2_ __attribute__((ext_vector_type(2)));
            f32x2_ ir2[4], cd2[4], sd2[4];
#pragma unroll
            for (int p = 0; p < 4; ++p) {
                ir2[p] = (f32x2_){__builtin_amdgcn_exp2f(-(float)(8 * fq + 2 * p) * (13.287712379549449f / 32.f)) * 0.15915494309189535f, __builtin_amdgcn_exp2f(-(float)(8 * fq + 2 * p + 1) * (13.287712379549449f / 32.f)) * 0.15915494309189535f};
                const f32x2_ r16 = ir2[p] * 16.f;
                cd2[p] = (f32x2_){__builtin_amdgcn_cosf(__builtin_amdgcn_fractf(r16.x)), __builtin_amdgcn_cosf(__builtin_amdgcn_fractf(r16.y))};
                sd2[p] = (f32x2_){__builtin_amdgcn_sinf(__builtin_amdgcn_fractf(r16.x)), __builtin_amdgcn_sinf(__builtin_amdgcn_fractf(r16.y))}; }
            const int head = 4 * (u.pn % 3) + wc;
            bf16_t* base = Z + (u.pn < 3 ? RQA : RKA) + ((size_t)(bb * HD_DIL + head) * S) * 64 + 8 * fq;
            float knrm = 0.f;
#pragma unroll
            for (int ai = 0; ai < 2; ++ai) {
                f32x2_ c2[4], s2[4];
                { const float pos0 = (float)((row0 + ai * HALF) & (S - 1));
#pragma unroll
                  for (int p = 0; p < 4; ++p) { const f32x2_ rv = ir2[p] * pos0; const float r0 = __builtin_amdgcn_fractf(rv.x), r1 = __builtin_amdgcn_fractf(rv.y);
                      c2[p] = (f32x2_){__builtin_amdgcn_cosf(r0), __builtin_amdgcn_cosf(r1)}; s2[p] = (f32x2_){__builtin_amdgcn_sinf(r0), __builtin_amdgcn_sinf(r1)}; } }
#pragma unroll
                for (int m = 0; m < 4; ++m) { const int row = row0 + ai * HALF + m * 16; const int spos = row & (S - 1);
                    if (m > 0) {
#pragma unroll
                        for (int p = 0; p < 4; ++p) { const f32x2_ cn = c2[p] * cd2[p] - s2[p] * sd2[p]; s2[p] = s2[p] * cd2[p] + c2[p] * sd2[p]; c2[p] = cn; } }
                    float o1[8], o2[8];
#pragma unroll
                    for (int p = 0; p < 4; ++p) { const int n = p >> 1, j = 2 * (p & 1);
                        const f32x2_ t1 = {acc[ai][0][m][n][j], acc[ai][0][m][n][j + 1]}, t2 = {acc[ai][1][m][n][j], acc[ai][1][m][n][j + 1]};
                        const f32x2_ a1 = t1 * c2[p] - t2 * s2[p], a2 = t2 * c2[p] + t1 * s2[p];
                        o1[2 * p] = a1.x; o1[2 * p + 1] = a1.y; o2[2 * p] = a2.x; o2[2 * p + 1] = a2.y; }
                    bf16_t* rowp = base + (size_t)spos * 64;
                    u32x4 w; w.x = cvt_pk_bf16(o1[0], o1[1]); w.y = cvt_pk_bf16(o1[2], o1[3]); w.z = cvt_pk_bf16(o1[4], o1[5]); w.w = cvt_pk_bf16(o1[6], o1[7]);
                    st16(rowp, w);
                    w.x = cvt_pk_bf16(o2[0], o2[1]); w.y = cvt_pk_bf16(o2[2], o2[3]); w.z = cvt_pk_bf16(o2[4], o2[5]); w.w = cvt_pk_bf16(o2[6], o2[7]);
                    st16(rowp + 32, w);
                    if (u.pn >= 3) { float p = 0.f;
#pragma unroll
                        for (int k = 0; k < 8; ++k) p += o1[k] * o1[k] + o2[k] * o2[k];
                        p = rows4_sum(p); knrm = fmaxf(knrm, p); }
                    __builtin_amdgcn_sched_barrier(0); } }
            if (u.pn >= 3) { knrm = row16_max(knrm);
                if (fr == 0 && fq == 0) atomicMax(kmaxd + bb * HD_DIL + head, __float_as_uint(knrm)); }
        } else {
            const bool fox = u.pn >= 9; const int nh = fox ? HD_FOX : HD_DIL;
            const size_t reg = u.pn < 9 ? RVA : (u.pn == 9 ? RQF : (u.pn == 10 ? RKF : RVF));
            const int head0 = (fox ? 0 : 4 * (u.pn - 6)) + (wc >> 1);
            bf16_t* base = Z + reg + 32 * (wc & 1) + 8 * fq;
#pragma unroll
            for (int ai = 0; ai < 2; ++ai)
#pragma unroll
                for (int m = 0; m < 4; ++m) { const int spos = (row0 + ai * HALF + m * 16) & (S - 1);
#pragma unroll
                    for (int bj = 0; bj < 2; ++bj) { const f32x4 v0 = acc[ai][bj][m][0], v1 = acc[ai][bj][m][1];
                        u32x4 w; w.x = cvt_pk_bf16(v0[0], v0[1]); w.y = cvt_pk_bf16(v0[2], v0[3]); w.z = cvt_pk_bf16(v1[0], v1[1]); w.w = cvt_pk_bf16(v1[2], v1[3]);
                        st16(base + ((size_t)(bb * nh + head0 + 2 * bj) * S + spos) * 64, w); } }
#ifndef FOX_NOKMAX
            if (u.pn == 10) {
#pragma unroll
                for (int bj = 0; bj < 2; ++bj) { float mxp = 0.f;
#pragma unroll
                    for (int ai = 0; ai < 2; ++ai)
#pragma unroll
                        for (int m = 0; m < 4; ++m) { const f32x4 a0 = acc[ai][bj][m][0], a1 = acc[ai][bj][m][1];
                            float p = (a0[0] * a0[0] + a0[1] * a0[1]) + (a0[2] * a0[2] + a0[3] * a0[3]) + (a1[0] * a1[0] + a1[1] * a1[1]) + (a1[2] * a1[2] + a1[3] * a1[3]);
                            p = rows4_sum(p); mxp = fmaxf(mxp, p); }
                    mxp = row16_max(mxp);
                    if (fr == 0 && fq == 0) atomicMax(kmax + ((bb * HD_FOX + head0 + 2 * bj) * 2 + (wc & 1)), __float_as_uint(mxp)); }
            }
#endif
        }
    }
};

template <class Epi, long BHSTEP  , int BN_ROWS, bool GATHER, bool GROUPED, bool FP8 = false, bool ALIGN = true>
__device__ __forceinline__ void gemm_phase(PG8_LAS unsigned char* lds, const Gemm g, const TileOrder& S, const Epi& E, const int tid) {
    const int wid = __builtin_amdgcn_readfirstlane(tid >> 6), lane = tid & 63, wr = wid >> 2, wc = wid & 3, fr = lane & 15, fq = lane >> 4;
    constexpr int K = 1024, KB = FP8 ? K : 2 * K  , nt = KB / (BK * 2)  ; constexpr long ESTRIDE = (long)K * KB;
    PG8_LAS int* gtab = (PG8_LAS int*)(lds + GTAB_OFF); PG8_LAS int* etab = (PG8_LAS int*)(lds + ETAB_OFF);
    unsigned voffB[2];
#pragma unroll
    for (int i = 0; i < 2; ++i) { int R, C; stage_rc(tid * 16 + i * 8192, R, C); const int Rb = (R & ~31) + perm32(R & 31); voffB[i] = (unsigned)(Rb * KB + C * 2); }
    if (GATHER || GROUPED) {
        Unit u; int i = 0;
        for (; i < GT_MAX && S.next(i, u); ++i) {
            if (GATHER && tid < 256) gtab[i * 256 + tid] = g.gather[u.pm * BM + tid];
            if (GROUPED && tid == 0) etab[i] = g.blk_e[u.pm];
        }
        __syncthreads();
    }
    const unsigned ldsw = (unsigned)wid * 1024u;
    const int aoff = lds_byte(wr * 64 + fr, fq * 8), boff = lds_byte(wc * 32 + fr, fq * 8);
#define PG8_SA(b, h) (((b) * 2 + (h)) * HTB)
#define PG8_SB(b, h) ((4 + (b) * 2 + (h)) * HTB)
#define PG8_STAGE(bufoff, gbase, voff) do { _Pragma("unroll") for (int _i = 0; _i < 2; ++_i) \
        __builtin_amdgcn_global_load_lds((const unsigned*)((const char*)(gbase) + (voff)[_i]), (PG8_LAS unsigned*)(lds + (bufoff) + ldsw + _i * 8192), 16, 0, 0); } while (0)
#define PG8_LDA(dst, b, h) do { _Pragma("unroll") for (int m = 0; m < 4; ++m) _Pragma("unroll") for (int k = 0; k < 2; ++k) dst[m][k] = *(const PG8_LAS bf16x8*)(lds + PG8_SA(b, h) + aoff + m * 2048 + k * 1024); } while (0)
#define PG8_LDB(dst, b, h) do { _Pragma("unroll") for (int n = 0; n < 2; ++n) _Pragma("unroll") for (int k = 0; k < 2; ++k) dst[n][k] = *(const PG8_LAS bf16x8*)(lds + PG8_SB(b, h) + boff + n * 2048 + k * 1024); } while (0)
#define PG8_MMA(ai, bj, At, Bt) do { __builtin_amdgcn_s_setprio(1); \
        if constexpr (FP8) { _Pragma("unroll") for (int m = 0; m < 4; ++m) _Pragma("unroll") for (int n = 0; n < 2; ++n) { \
            typedef int v4i_ __attribute__((ext_vector_type(4))); typedef int v8i_ __attribute__((ext_vector_type(8))); \
            const v8i_ a8 = __builtin_shufflevector(__builtin_bit_cast(v4i_, At[m][0]), __builtin_bit_cast(v4i_, At[m][1]), 0, 1, 2, 3, 4, 5, 6, 7); \
            const v8i_ b8 = __builtin_shufflevector(__builtin_bit_cast(v4i_, Bt[n][0]), __builtin_bit_cast(v4i_, Bt[n][1]), 0, 1, 2, 3, 4, 5, 6, 7); \
            acc[ai][bj][m][n] = __builtin_amdgcn_mfma_scale_f32_16x16x128_f8f6f4(b8, a8, acc[ai][bj][m][n], 0, 0, 0, 0x7f7f7f7f, 0, 0x7f7f7f7f); } } \
        else { _Pragma("unroll") for (int m = 0; m < 4; ++m) _Pragma("unroll") for (int n = 0; n < 2; ++n) _Pragma("unroll") for (int k = 0; k < 2; ++k) \
            acc[ai][bj][m][n] = __builtin_amdgcn_mfma_f32_16x16x32_bf16(Bt[n][k], At[m][k], acc[ai][bj][m][n], 0, 0, 0); } \
        __builtin_amdgcn_s_setprio(0); } while (0)
#define PG8_WAIT_V(n) asm volatile("s_waitcnt vmcnt(" #n ")" ::: "memory")
#define PG8_WAIT_L(n) asm volatile("s_waitcnt lgkmcnt(" #n ")" ::: "memory")
#define PG8_BAR __builtin_amdgcn_s_barrier()
#define PG8_SCHED __builtin_amdgcn_sched_barrier(0)
#define PG8_UNIT_ADDR(u, ui_, ao, b0) do { \
        _Pragma("unroll") for (int h = 0; h < 2; ++h) _Pragma("unroll") for (int i = 0; i < 2; ++i) { int R_, C_; stage_rc(tid * 16 + i * 8192, R_, C_); \
            int row_ = (u).pm * BM + h * HALF + R_; if (GATHER) row_ = gtab[(ui_) * 256 + h * HALF + R_]; \
            ao[h][i] = (unsigned)(row_ * KB + C_ * 2); } \
        const int e_ = GROUPED ? __builtin_amdgcn_readfirstlane(etab[(ui_)]) : 0; \
        b0 = (const char*)g.B0 + (size_t)e_ * ESTRIDE + (size_t)(u).pn * BN_ROWS * KB; } while (0)
    Unit cur, nxt; int ui = 0;
    if (!S.next(0, cur)) return;
    f32x4 acc[2][2][4][2];
#pragma unroll
    for (int a = 0; a < 2; ++a)
#pragma unroll
        for (int b = 0; b < 2; ++b)
#pragma unroll
            for (int m = 0; m < 4; ++m)
#pragma unroll
                for (int n = 0; n < 2; ++n) acc[a][b][m][n] = (f32x4){0.f, 0.f, 0.f, 0.f};
    bf16x8 At[4][2], B0[2][2], B1[2][2];
    unsigned aC[2][2]; const char *cB0, *nB0; constexpr size_t bh = (size_t)BHSTEP;
    const char* gA = (const char*)g.A;
    PG8_UNIT_ADDR(cur, 0, aC, cB0);
    const size_t kstep = (size_t)(BK * 2);
    PG8_STAGE(PG8_SB(0, 0), cB0, voffB); PG8_STAGE(PG8_SB(0, 1), cB0 + bh, voffB); PG8_STAGE(PG8_SA(0, 0), gA, aC[0]); PG8_STAGE(PG8_SA(0, 1), gA, aC[1]);
    if (wr == 1) PG8_BAR;
    PG8_WAIT_V(2); PG8_BAR;
    PG8_STAGE(PG8_SB(1, 0), cB0 + kstep, voffB); PG8_STAGE(PG8_SA(1, 0), gA + kstep, aC[0]); PG8_STAGE(PG8_SB(1, 1), cB0 + bh + kstep, voffB);
    PG8_WAIT_V(6); PG8_BAR;
    for (;;) {
        const bool has_next = S.next(ui + 1, nxt);
        nB0 = cB0;
        for (int t = 0; t < nt; t += 2) {
            const bool last = (t == nt - 2);
            const char* a1 = gA + (size_t)(t + 1) * kstep;
            const char* a2 = last ? gA : gA + (size_t)(t + 2) * kstep; const char* a3 = a2 + kstep;
            PG8_LDB(B0, 0, 0); PG8_LDB(B1, 0, 1); PG8_SCHED; PG8_LDA(At, 0, 0); PG8_STAGE(PG8_SA(1, 1), a1, aC[1]);
            PG8_WAIT_V(8); PG8_WAIT_L(0); PG8_BAR; PG8_MMA(0, 0, At, B0); PG8_MMA(0, 1, At, B1); PG8_BAR; PG8_SCHED;
            if (last && has_next) { PG8_UNIT_ADDR(nxt, ui + 1, aC, nB0); }
            const char* b20 = last ? nB0 : cB0 + (size_t)(t + 2) * kstep; const char* b30 = b20 + kstep;
            PG8_LDA(At, 0, 1); PG8_STAGE(PG8_SB(0, 0), b20, voffB); PG8_STAGE(PG8_SB(0, 1), b20 + bh, voffB); PG8_STAGE(PG8_SA(0, 0), a2, aC[0]);
            PG8_WAIT_V(8); PG8_WAIT_L(0); PG8_BAR; PG8_MMA(1, 0, At, B0); PG8_MMA(1, 1, At, B1); PG8_BAR; PG8_SCHED;
            PG8_LDB(B0, 1, 0); PG8_LDB(B1, 1, 1); PG8_SCHED; PG8_LDA(At, 1, 0); PG8_STAGE(PG8_SA(0, 1), a2, aC[1]);
            PG8_WAIT_V(8); PG8_WAIT_L(0); PG8_BAR; PG8_MMA(0, 0, At, B0); PG8_MMA(0, 1, At, B1); PG8_BAR; PG8_SCHED;
            PG8_LDA(At, 1, 1); PG8_STAGE(PG8_SB(1, 0), b30, voffB); PG8_STAGE(PG8_SB(1, 1), b30 + bh, voffB); PG8_STAGE(PG8_SA(1, 0), a3, aC[0]);
            PG8_WAIT_V(8); PG8_WAIT_L(0); PG8_BAR; PG8_MMA(1, 0, At, B0); PG8_MMA(1, 1, At, B1); PG8_BAR; PG8_SCHED;
        }
        if (ALIGN) { if (wr == 0) PG8_BAR; }
        { int t2 = tid; asm volatile("" : "+v"(t2));
          E(acc, cur, wr, wc, t2 & 15, (t2 & 63) >> 4); }
        if (!has_next) break;
#pragma unroll
        for (int a = 0; a < 2; ++a)
#pragma unroll
            for (int b = 0; b < 2; ++b)
#pragma unroll
                for (int m = 0; m < 4; ++m)
#pragma unroll
                    for (int n = 0; n < 2; ++n) acc[a][b][m][n] = (f32x4){0.f, 0.f, 0.f, 0.f};
        cur = nxt; cB0 = nB0; ++ui;
        if (ALIGN) { if (wr == 1) PG8_BAR; }
    }
    PG8_WAIT_V(0);
    if (!ALIGN) { if (wr == 0) PG8_BAR; }
    PG8_BAR;
#undef PG8_SA
#undef PG8_SB
#undef PG8_STAGE
#undef PG8_LDA
#undef PG8_LDB
#undef PG8_MMA
#undef PG8_WAIT_V
#undef PG8_WAIT_L
#undef PG8_BAR
#undef PG8_SCHED
#undef PG8_UNIT_ADDR
}
}

namespace att {
using bf16x8 = __attribute__((ext_vector_type(8))) short;
using s16x4 = __attribute__((ext_vector_type(4))) short;
using f32x16 = __attribute__((ext_vector_type(16))) float;
using u32x4 = __attribute__((ext_vector_type(4))) unsigned;
typedef __attribute__((address_space(3))) const char* lds_cptr;
typedef __attribute__((address_space(3))) char* lds_ptr;
typedef short v4i16_t __attribute__((ext_vector_type(4)));
typedef float f32x2_t __attribute__((ext_vector_type(2))); typedef __bf16 bf16x2_t __attribute__((ext_vector_type(2)));
__device__ __forceinline__ int crow(int r, int hi) { return (r & 3) + 8 * (r >> 2) + 4 * hi; }
__device__ __forceinline__ unsigned cvtpk_s(float lo, float hi) { f32x2_t v = {lo, hi}; bf16x2_t b = __builtin_convertvector(v, bf16x2_t); return __builtin_bit_cast(unsigned, b); }
__device__ __forceinline__ void glds16(const void* gsrc, unsigned lds_dst) { unsigned keep;
    asm volatile("s_mov_b32 %0, m0\n\ts_mov_b32 m0, %2\n\ts_nop 0\n\tglobal_load_lds_dwordx4 %1, off\n\ts_mov_b32 m0, %0" : "=&s"(keep) : "v"(gsrc), "s"(lds_dst) : "memory"); }
__device__ __forceinline__ s16x4 vtr(lds_cptr p) { return __builtin_bit_cast(s16x4, __builtin_amdgcn_ds_read_tr16_b64_v4i16((__attribute__((address_space(3))) v4i16_t*)p)); }
#define ATT_WAIT_BAR(N) asm volatile("s_waitcnt vmcnt(" #N ") lgkmcnt(0)\n\ts_barrier" ::: "memory")

struct St { f32x16 o0, o1; float m, l; };
__device__ __forceinline__ float xhalf_max(float v) { auto rr = __builtin_amdgcn_permlane32_swap(__float_as_uint(v), __float_as_uint(v), false, false); return fmaxf(__uint_as_float(rr[0]), __uint_as_float(rr[1])); }
__device__ __forceinline__ float xhalf_sum(float v) { auto rr = __builtin_amdgcn_permlane32_swap(__float_as_uint(v), __float_as_uint(v), false, false); return __uint_as_float(rr[0]) + __uint_as_float(rr[1]); }

__device__ __forceinline__ f32x16 qk32(const bf16x8 (&qr)[4], lds_cptr kimg, const f32x16& c0, int lane) {
    const int r32 = lane & 31, hi = lane >> 5;
    const lds_cptr kr = kimg + r32 * 128; const int y = hi ^ ((r32 >> 1) & 7);
    const bf16x8 k0 = *(const __attribute__((address_space(3))) bf16x8*)(kr + ((0 ^ y) << 4)), k1 = *(const __attribute__((address_space(3))) bf16x8*)(kr + ((2 ^ y) << 4)),
                 k2 = *(const __attribute__((address_space(3))) bf16x8*)(kr + ((4 ^ y) << 4)), k3 = *(const __attribute__((address_space(3))) bf16x8*)(kr + ((6 ^ y) << 4));
    f32x16 p = __builtin_amdgcn_mfma_f32_32x32x16_bf16(k0, qr[0], c0, 0, 0, 0);
    p = __builtin_amdgcn_mfma_f32_32x32x16_bf16(k1, qr[1], p, 0, 0, 0);
    p = __builtin_amdgcn_mfma_f32_32x32x16_bf16(k2, qr[2], p, 0, 0, 0);
    p = __builtin_amdgcn_mfma_f32_32x32x16_bf16(k3, qr[3], p, 0, 0, 0);
    return p;
}
template <int NB>
__device__ __forceinline__ void softmax_upd(St& s, f32x16 (&p)[NB], bf16x8 (&pa)[2 * NB]) {
    float mx = p[0][0];
#pragma unroll
    for (int b = 0; b < NB; ++b)
#pragma unroll
        for (int r = 0; r < 16; ++r) mx = fmaxf(mx, p[b][r]);
    mx = xhalf_max(mx);
    const float mnew = fmaxf(s.m, mx);
    const float f = __builtin_amdgcn_exp2f(s.m - mnew);
    s.m = mnew;
#pragma unroll
    for (int r = 0; r < 16; ++r) { s.o0[r] *= f; s.o1[r] *= f; }
    float sum = 0.f;
#pragma unroll
    for (int b = 0; b < NB; ++b)
#pragma unroll
        for (int r = 0; r < 16; ++r) { p[b][r] = __builtin_amdgcn_exp2f(p[b][r] - mnew); sum += p[b][r]; }
    s.l = s.l * f + sum;
#pragma unroll
    for (int b = 0; b < NB; ++b) { u32x4 w0, w1;
        w0[0] = cvtpk_s(p[b][0], p[b][1]); w0[1] = cvtpk_s(p[b][2], p[b][3]); w0[2] = cvtpk_s(p[b][4], p[b][5]); w0[3] = cvtpk_s(p[b][6], p[b][7]);
        w1[0] = cvtpk_s(p[b][8], p[b][9]); w1[1] = cvtpk_s(p[b][10], p[b][11]); w1[2] = cvtpk_s(p[b][12], p[b][13]); w1[3] = cvtpk_s(p[b][14], p[b][15]);
        pa[2 * b] = __builtin_bit_cast(bf16x8, w0); pa[2 * b + 1] = __builtin_bit_cast(bf16x8, w1); }
}
__device__ __forceinline__ void pv32(St& s, const bf16x8& pa0, const bf16x8& pa1, lds_cptr vimg, int lane) {
    const int hi = lane >> 5;
    const int b1 = (lane >> 3) & 1;
    const lds_cptr vp = vimg + (4 * hi + ((lane & 15) >> 2)) * 128 + ((lane >> 4) & 1) * 32 + (lane & 3) * 8;
    const lds_cptr vpd[2] = {vp + (b1 << 6), vp + ((b1 ^ 1) << 6)};
#define ATT_VF(dh, ks) ({ const s16x4 lo_ = vtr(vpd[dh] + (ks) * 2048), hi_ = vtr(vpd[dh] + (ks) * 2048 + 1024); (bf16x8){lo_[0], lo_[1], lo_[2], lo_[3], hi_[0], hi_[1], hi_[2], hi_[3]}; })
    const bf16x8 v00 = ATT_VF(0, 0), v10 = ATT_VF(1, 0), v01 = ATT_VF(0, 1), v11 = ATT_VF(1, 1);
    s.o0 = __builtin_amdgcn_mfma_f32_32x32x16_bf16(v00, pa0, s.o0, 0, 0, 0);
    s.o1 = __builtin_amdgcn_mfma_f32_32x32x16_bf16(v10, pa0, s.o1, 0, 0, 0);
    s.o0 = __builtin_amdgcn_mfma_f32_32x32x16_bf16(v01, pa1, s.o0, 0, 0, 0);
    s.o1 = __builtin_amdgcn_mfma_f32_32x32x16_bf16(v11, pa1, s.o1, 0, 0, 0);
#undef ATT_VF
}

template <class RowPtr>
__device__ __forceinline__ void finish(St& s, __attribute__((address_space(3))) bf16* stg, int lane, const RowPtr& rowptr) {
    const int r32 = lane & 31, hi = lane >> 5;
    s.l = xhalf_sum(s.l);
    const float il = __builtin_amdgcn_rcpf(s.l);
    typedef unsigned u32x2 __attribute__((ext_vector_type(2)));
#pragma unroll
    for (int g = 0; g < 4; ++g) {
        u32x2 w0, w1;
        w0[0] = cvtpk_s(s.o0[4 * g] * il, s.o0[4 * g + 1] * il); w0[1] = cvtpk_s(s.o0[4 * g + 2] * il, s.o0[4 * g + 3] * il);
        w1[0] = cvtpk_s(s.o1[4 * g] * il, s.o1[4 * g + 1] * il); w1[1] = cvtpk_s(s.o1[4 * g + 2] * il, s.o1[4 * g + 3] * il);
        *(__attribute__((address_space(3))) u32x2*)(stg + r32 * 64 + 4 * ((2 * g + hi) ^ (2 * (r32 & 7)))) = w0;
        *(__attribute__((address_space(3))) u32x2*)(stg + r32 * 64 + 4 * ((8 + 2 * g + hi) ^ (2 * (r32 & 7)))) = w1; }
    asm volatile("s_waitcnt lgkmcnt(0)" ::: "memory");
#pragma unroll
    for (int i = 0; i < 4; ++i) { const int row = i * 8 + (lane >> 3), ch = lane & 7; const u32x4 v = *(const __attribute__((address_space(3))) u32x4*)(stg + row * 64 + 8 * (ch ^ (row & 7)));
        __builtin_nontemporal_store(v, (u32x4*)(rowptr(row) + ch * 8)); }
    asm volatile("s_waitcnt lgkmcnt(0)" ::: "memory");
}

template <int NB>
__device__ __forceinline__ void att_step(St& s, float& ref, float& fprev, const bf16x8 (&qr)[4], lds_cptr kimg, lds_cptr vimg, unsigned bw0, unsigned bw1, const f32x16& c0, const f32x16& c1, int lane) {
    const int hi = lane >> 5;
    const unsigned one2 = 0x3f803f80u;
    const unsigned nrh = f2bf(-ref); const unsigned nrl = f2bf(-ref - __uint_as_float(nrh << 16));
    u32x4 qxw = {one2, nrh | (nrl << 16), 0u, 0u}; u32x4 kx0w = {bw0, one2, 0u, 0u}; u32x4 kx1w = {bw1, one2, 0u, 0u};
    if (hi) { qxw = (u32x4){0u, 0u, 0u, 0u}; kx0w = qxw; kx1w = qxw; }
    const bf16x8 qx = __builtin_bit_cast(bf16x8, qxw), kx0 = __builtin_bit_cast(bf16x8, kx0w), kx1 = __builtin_bit_cast(bf16x8, kx1w);
    f32x16 p[NB];
    p[0] = qk32(qr, kimg, c0, lane); if (NB == 2) p[NB - 1] = qk32(qr, kimg + 4096, c1, lane);
    p[0] = __builtin_amdgcn_mfma_f32_32x32x16_bf16(kx0, qx, p[0], 0, 0, 0);
    if (NB == 2) p[NB - 1] = __builtin_amdgcn_mfma_f32_32x32x16_bf16(kx1, qx, p[NB - 1], 0, 0, 0);
#pragma unroll
    for (int r = 0; r < 16; ++r) { s.o0[r] *= fprev; s.o1[r] *= fprev; }
    float mx = p[0][0];
#pragma unroll
    for (int b = 0; b < NB; ++b)
#pragma unroll
        for (int r = 0; r < 16; ++r) mx = fmaxf(mx, p[b][r]);
    mx = xhalf_max(mx);
    float sum = 0.f;
#pragma unroll
    for (int b = 0; b < NB; ++b)
#pragma unroll
        for (int r = 0; r < 16; ++r) { p[b][r] = __builtin_amdgcn_exp2f(p[b][r]); sum += p[b][r]; }
    s.l = s.l * fprev + sum;
    const float d = fmaxf(mx, 0.f); ref += d; fprev = __builtin_amdgcn_exp2f(-d);
    bf16x8 pa[2 * NB];
#pragma unroll
    for (int b = 0; b < NB; ++b) { u32x4 w0, w1;
        w0[0] = cvtpk_s(p[b][0], p[b][1]); w0[1] = cvtpk_s(p[b][2], p[b][3]); w0[2] = cvtpk_s(p[b][4], p[b][5]); w0[3] = cvtpk_s(p[b][6], p[b][7]);
        w1[0] = cvtpk_s(p[b][8], p[b][9]); w1[1] = cvtpk_s(p[b][10], p[b][11]); w1[2] = cvtpk_s(p[b][12], p[b][13]); w1[3] = cvtpk_s(p[b][14], p[b][15]);
        pa[2 * b] = __builtin_bit_cast(bf16x8, w0); pa[2 * b + 1] = __builtin_bit_cast(bf16x8, w1); }
    pv32(s, pa[0], pa[1], vimg, lane); if (NB == 2) pv32(s, pa[2 * NB - 2], pa[2 * NB - 1], vimg + 4096, lane);
}

constexpr int L_K = 0, L_V = 49152;
constexpr int FOX_SLOT = 16384;
constexpr int L_KB = 49152;
constexpr int L_RED = 65536;
constexpr int L_WSF = 98304;
constexpr int L_OST = 100352;
constexpr int L_END = L_OST + 32768;

struct DilU { int b, h, br, rr, rho, j; };
__device__ __forceinline__ DilU dil_decode(int u) {
    DilU d; const int bh = u / 48, r = u % 48; d.b = bh / 12; d.h = bh % 12;
    if (r < 16) { d.br = 0; d.rr = 1; d.rho = 0; d.j = r; } else if (r < 32) { d.br = 1; d.rr = 4; d.rho = (r - 16) >> 2; d.j = (r - 16) & 3; } else { d.br = 2; d.rr = 16; d.rho = r - 32; d.j = 0; }
    return d;
}
__device__ __forceinline__ void dil_issue(const DilU& u, const bf16* Z, int tid, u32x4 (&kv)[12], u32x4 (&qv)[4]) {
    const size_t hb = ((size_t)(u.b * HD_DIL + u.h) * S) * 64;
    const int e0 = 256 * u.j - 128, c = tid & 7;
    const bf16* r0 = Z + hb + (size_t)u.rho * 64 + c * 8;
    const ptrdiff_t est = (ptrdiff_t)u.rr * 64;
    const bf16* rp = r0 + (ptrdiff_t)(e0 + (tid >> 3)) * est;
#pragma unroll
    for (int i = 0; i < 6; ++i) { const bf16* p = (u.j == 0 && i < 2) ? r0 : rp + (ptrdiff_t)(64 * i) * est;
        kv[i] = *(const u32x4*)(p + RKA); kv[6 + i] = *(const u32x4*)(p + RVA); }
    const bf16* qp = rp + (ptrdiff_t)128 * est + RQA;
#pragma unroll
    for (int i = 0; i < 4; ++i) qv[i] = *(const u32x4*)(qp + (ptrdiff_t)(64 * i) * est);
}
__device__ __forceinline__ void dil_commit(char* shm, int tid, const u32x4 (&kv)[12], const u32x4 (&qv)[4]) {
    const lds_ptr base = (lds_ptr)shm; const int c = tid & 7;
#pragma unroll
    for (int i = 0; i < 6; ++i) { const int row = (tid >> 3) + 64 * i;
        *(__attribute__((address_space(3))) u32x4*)(base + L_K + row * 128 + ((c ^ ((row >> 1) & 7)) << 4)) = kv[i];
        *(__attribute__((address_space(3))) u32x4*)(base + L_V + row * 128 + ((c ^ (((row >> 1) & 1) << 2)) << 4)) = kv[6 + i]; }
#pragma unroll
    for (int i = 0; i < 4; ++i) { const int row = (tid >> 3) + 64 * i;
        *(__attribute__((address_space(3))) u32x4*)(base + L_OST + row * 128 + ((c ^ ((row >> 1) & 7)) << 4)) = qv[i]; }
}
__device__ __forceinline__ void dil_qfrag(char* shm, int tid, bf16x8 (&qr)[4]) {
    const int lane = tid & 63, r32 = lane & 31, hi = lane >> 5, wid = tid >> 6; const int y = hi ^ ((r32 >> 1) & 7);
    const lds_cptr qrow = (lds_cptr)shm + L_OST + (32 * wid + r32) * 128;
#pragma unroll
    for (int d0 = 0; d0 < 4; ++d0) qr[d0] = *(const __attribute__((address_space(3))) bf16x8*)(qrow + (((2 * d0) ^ y) << 4));
}
template <class PreFinish>
__device__ __forceinline__ void dil_compute(const DilU& u, const bf16x8 (&qr)[4], bf16* OP, float* ML, char* shm, int tid, const float bk2, const PreFinish& pre_finish) {
    const int lane = tid & 63, r32 = lane & 31, hi = lane >> 5; const int wid = __builtin_amdgcn_readfirstlane(tid >> 6);
    const lds_cptr shm3 = (lds_cptr)shm;
    __attribute__((address_space(3))) bf16* stg = (__attribute__((address_space(3))) bf16*)(shm3 + L_OST) + wid * 2048;
    const lds_cptr kw = shm3 + L_K + 32 * wid * 128, vw = shm3 + L_V + 32 * wid * 128;
    const int nlive0 = (u.j == 0) ? 4 - wid : 0;
    float qs = 0.f;
#pragma unroll
    for (int d0 = 0; d0 < 4; ++d0) { const u32x4 w = __builtin_bit_cast(u32x4, qr[d0]);
#pragma unroll
        for (int j = 0; j < 4; ++j) { const float lo = __uint_as_float(w[j] << 16), hi_ = __uint_as_float(w[j] & 0xffff0000u); qs += lo * lo + hi_ * hi_; } }
    qs = xhalf_sum(qs);
    const bool fast = !__any(!(qs * bk2 * 1.05f <= 4096.f));
    St s; s.o0 = f32x16{}; s.o1 = f32x16{}; s.m = 0.f; s.l = 0.f;
    float mref = 0.f, lscale = 1.f;
    if (fast) {
#pragma unroll
        for (int b = 0; b < 5; ++b) {
            if (b < nlive0) continue;
            f32x16 c;
#pragma unroll
            for (int r = 0; r < 16; ++r) c[r] = (b == 0 && r32 > crow(r, hi)) || (b == 4 && r32 < crow(r, hi)) ? -INFINITY : 0.f;
            f32x16 p = qk32(qr, kw + b * 4096, c, lane);
            float sum = 0.f;
#pragma unroll
            for (int r = 0; r < 16; ++r) { p[r] = __builtin_amdgcn_exp2f(p[r]); sum += p[r]; }
            s.l += sum;
            u32x4 w0, w1;
            w0[0] = cvtpk_s(p[0], p[1]); w0[1] = cvtpk_s(p[2], p[3]); w0[2] = cvtpk_s(p[4], p[5]); w0[3] = cvtpk_s(p[6], p[7]);
            w1[0] = cvtpk_s(p[8], p[9]); w1[1] = cvtpk_s(p[10], p[11]); w1[2] = cvtpk_s(p[12], p[13]); w1[3] = cvtpk_s(p[14], p[15]);
            pv32(s, __builtin_bit_cast(bf16x8, w0), __builtin_bit_cast(bf16x8, w1), vw + b * 4096, lane);
        }
    } else {
        float ref = sqrtf(qs * bk2 * 1.05f), fprev = 1.f;
#pragma nounroll
        for (int kbi = nlive0; kbi < 5; ++kbi) {
            f32x16 c;
#pragma unroll
            for (int r = 0; r < 16; ++r) c[r] = (kbi == 0 && r32 > crow(r, hi)) || (kbi == 4 && r32 < crow(r, hi)) ? -INFINITY : 0.f;
            att_step<1>(s, ref, fprev, qr, kw + kbi * 4096, vw + kbi * 4096, 0u, 0u, c, c, lane);
        }
        mref = ref; lscale = fprev;
    }
    bf16* OPb = OP + ((size_t)u.br * T + (size_t)u.b * S) * 768 + u.h * 64;
    const int eb = 256 * u.j + 32 * wid;
    pre_finish();
    finish(s, stg, lane, [&](int q) { return OPb + (size_t)(u.rho + u.rr * (eb + q)) * 768; });
    { const int tq = u.rho + u.rr * (eb + r32); float* mp = ML + ((((size_t)u.br * T + (size_t)u.b * S + (tq & ~15)) * 12) + (size_t)u.h * 16 + (tq & 15)) * 2; mp[0] = mref; mp[1] = s.l * lscale; }
}

__device__ __forceinline__ void fox_bias(int b, int h, int n, const float* logf, char* shm, const int tid) {
    const int lane = tid & 63, wid = tid >> 6;
    __attribute__((address_space(3))) float* kb = (__attribute__((address_space(3))) float*)((lds_cptr)shm + L_KB);
    __attribute__((address_space(3))) float* red = (__attribute__((address_space(3))) float*)((lds_cptr)shm + L_RED);
    float v[8]; float tot = 0.f;
#pragma unroll
    for (int i = 0; i < 8; ++i) { const int sidx = tid * 8 + i; v[i] = sidx < n ? logf[((size_t)b * S + sidx) * 4 + h] : 0.f; tot += v[i]; v[i] = tot; }
    float inc = tot;
#pragma unroll
    for (int o = 1; o < 64; o <<= 1) { const float x = __shfl_up(inc, o); if (lane >= o) inc += x; }
    if (lane == 63) red[wid] = inc;
    __syncthreads();
    float base = inc - tot;
    for (int w = 0; w < wid; ++w) base += red[w];
#pragma unroll
    for (int i = 0; i < 8; ++i) { const float bv = -(base + v[i]) * LOG2E; const unsigned bh = f2bf(bv); const unsigned bl = f2bf(bv - __uint_as_float(bh << 16));
        kb[tid * 8 + i] = __uint_as_float(bh | (bl << 16)); }
    __syncthreads();
}

template <bool DIAG>
__device__ __forceinline__ void fox_tile(St& s, float& ref, float& fprev, const bf16x8 (&qr)[4], lds_cptr kimg, lds_cptr vimg, lds_cptr kbias_t, int qrel  , const f32x16& zero16, int lane) {
    const int r32 = lane & 31, hi = lane >> 5;
    const unsigned bw0 = __float_as_uint(*(const __attribute__((address_space(3))) float*)(kbias_t + r32 * 4)), bw1 = __float_as_uint(*(const __attribute__((address_space(3))) float*)(kbias_t + (32 + r32) * 4));
    f32x16 c0 = zero16, c1 = zero16;
    if (DIAG) {
#pragma unroll
        for (int r = 0; r < 16; ++r) { const int k = crow(r, hi); c0[r] = k > qrel ? -INFINITY : 0.f; c1[r] = k + 32 > qrel ? -INFINITY : 0.f; }
    }
    att_step<2>(s, ref, fprev, qr, kimg, vimg, bw0, bw1, c0, c1, lane);
}
__device__ __forceinline__ void fox_unit(int b, int h, int qb, const bf16* Z, bf16* OF, char* shm, const int tid, const float bk2) {
    const int lane = tid & 63, r32 = lane & 31, hi = lane >> 5; const int wid = __builtin_amdgcn_readfirstlane(tid >> 6);
    const unsigned lds0 = (unsigned)(uintptr_t)shm;
    const lds_cptr shm3 = (lds_cptr)shm;
    __attribute__((address_space(3))) bf16* stg = (__attribute__((address_space(3))) bf16*)(shm3 + L_OST) + wid * 2048;
    const lds_cptr kbias = shm3 + L_KB;
    const size_t hb = ((size_t)(b * HD_FOX + h) * S) * 64;
    const int q0 = qb * 256;
    const int NTw = (q0 + 32 * wid) / 64 + 1;
    const int NT = (q0 + 256) / 64;
    const int drow = 8 * wid + (lane >> 3);
    const bf16* ksrc = Z + RKF + hb + (size_t)drow * 64 + (((lane & 7) ^ ((drow >> 1) & 7)) << 3);
    const bf16* vsrc = Z + RVF + hb + (size_t)drow * 64 + (((lane & 7) ^ (((drow >> 1) & 1) << 2)) << 3);
    const unsigned kdst = lds0 + L_K + wid * 1024, vdst = lds0 + L_K + 8192 + wid * 1024;
#define FOX_DMA(t, slot) do { glds16(ksrc + (size_t)(t) * 64 * 64, (unsigned)__builtin_amdgcn_readfirstlane(kdst + (slot) * FOX_SLOT)); \
                              glds16(vsrc + (size_t)(t) * 64 * 64, (unsigned)__builtin_amdgcn_readfirstlane(vdst + (slot) * FOX_SLOT)); } while (0)
    const int qrow = q0 + 32 * wid + r32;
    bf16x8 qr[4];
#pragma unroll
    for (int d0 = 0; d0 < 4; ++d0) qr[d0] = *(const bf16x8*)(Z + RQF + hb + (size_t)qrow * 64 + d0 * 16 + hi * 8);
    int t0; float ref0;
    { float qs = 0.f;
#pragma unroll
      for (int d0 = 0; d0 < 4; ++d0) { const u32x4 w = __builtin_bit_cast(u32x4, qr[d0]);
#pragma unroll
          for (int j = 0; j < 4; ++j) { const float lo = __uint_as_float(w[j] << 16), hi_ = __uint_as_float(w[j] & 0xffff0000u); qs += lo * lo + hi_ * hi_; } }
      qs = xhalf_sum(qs);
#pragma unroll
      for (int o = 1; o < 32; o <<= 1) qs = fmaxf(qs, __shfl_xor(qs, o));
      __attribute__((address_space(3))) float* red = (__attribute__((address_space(3))) float*)(shm3 + L_RED);
      if (lane == 0) red[wid] = qs;
      asm volatile("s_waitcnt lgkmcnt(0)\n\ts_barrier" ::: "memory");
      float bq2 = red[0];
#pragma unroll
      for (int w = 1; w < 8; ++w) bq2 = fmaxf(bq2, red[w]);
      const float th = 64.f + 2.05f * sqrtf(bq2 * bk2) + 2.f;
      const float* kbf = (const float*)0; (void)kbf;
      auto kbv = [&](int key) { const unsigned w = __float_as_uint(*(const __attribute__((address_space(3))) float*)(kbias + key * 4)); return __uint_as_float(w << 16) + __uint_as_float(w & 0xffff0000u); };
      const float kq0 = kbv(q0);
      { const bool cnd = lane < 4 * qb && (kq0 - kbv(64 * (lane < 4 * qb ? lane : 0) + 63) > th);
        const unsigned long long mk = __ballot(cnd); t0 = __builtin_ctzll(~mk); }
      t0 = __builtin_amdgcn_readfirstlane(t0);
#ifdef FOX_NOPRUNE
      t0 = 0;
#endif
#ifdef FOX_FORCE2
      t0 = 4 * qb < 2 ? 4 * qb : 2;
#endif
      ref0 = kbv(64 * t0);
      asm volatile("s_waitcnt lgkmcnt(0)\n\ts_barrier" ::: "memory");
    }
    FOX_DMA(t0, 0); if (t0 + 1 < NT) FOX_DMA(t0 + 1, 1);
    St s; s.o0 = f32x16{}; s.o1 = f32x16{}; s.m = 0.f; s.l = 0.f;
    float ref = ref0, fprev = 1.f;
    f32x16 zero16 = f32x16{}; asm volatile("" : "+v"(zero16));
    asm volatile("" : "+v"(qr[0]), "+v"(qr[1]), "+v"(qr[2]), "+v"(qr[3]));
    asm volatile("s_waitcnt vmcnt(0)" ::: "memory");
    int slot = 0;
    for (int t = t0; t < NT; ++t) {
        if (t + 1 < NT && t > t0) { ATT_WAIT_BAR(2); } else { ATT_WAIT_BAR(0); }
        if (t + 2 < NT) { const int s2 = slot == 0 ? 2 : slot - 1; FOX_DMA(t + 2, s2); }
        const lds_cptr kt = shm3 + L_K + slot * FOX_SLOT, vt = kt + 8192;
        if (t < NTw - 1) fox_tile<false>(s, ref, fprev, qr, kt, vt, kbias + 64 * t * 4, 0, zero16, lane);
        else if (t == NTw - 1) fox_tile<true>(s, ref, fprev, qr, kt, vt, kbias + 64 * t * 4, qrow - 64 * t, zero16, lane);
        slot = slot == 2 ? 0 : slot + 1;
    }
#undef FOX_DMA
    bf16* OFb = OF + ((size_t)b * S + q0 + 32 * wid) * 256 + h * 64;
    finish(s, stg, lane, [&](int q) { return OFb + (size_t)q * 256; });
    asm volatile("s_waitcnt lgkmcnt(0)\n\ts_barrier" ::: "memory");
}
}

constexpr int NWAVES = 8;
constexpr int RING_BYTES = 131072;
constexpr int MISC_OFF = pg8::ETAB_OFF + 256;
constexpr int LDS_BYTES = 147456;
static_assert(MISC_OFF + 256 <= LDS_BYTES && att::L_END <= MISC_OFF, "LDS map");

#define GAS __attribute__((address_space(1)))
#define LAS __attribute__((address_space(3)))
#include <type_traits>
typedef unsigned v4u __attribute__((ext_vector_type(4)));
typedef float f32x4 __attribute__((ext_vector_type(4)));
typedef GAS unsigned gu32;
#define RLX_AGENT __ATOMIC_RELAXED, __HIP_MEMORY_SCOPE_AGENT
#define LDS_WAIT() asm volatile("s_waitcnt lgkmcnt(0)" ::: "memory")

#define XB_TMO      128
#define XB_XCNT(j)  (256  + 64 * (j))
#define XB_XSUB(j)  (1280 + 64 * (j))
#define XB_XGEN(j)  (2304 + 64 * (j))
#define XB_TOP      3328
#define XB_TOPGEN   3392
#define XCD_BAR_WORDS 3456
#define XB_SPIN_CAP (1u << 20)
__device__ __forceinline__ unsigned xb_ld(unsigned* p)              { return __hip_atomic_load(p, __ATOMIC_RELAXED, __HIP_MEMORY_SCOPE_AGENT); }
__device__ __forceinline__ unsigned xb_add(unsigned* p, unsigned v) { return __hip_atomic_fetch_add(p, v, __ATOMIC_RELAXED, __HIP_MEMORY_SCOPE_AGENT); }
__device__ __forceinline__ unsigned xb_xcc_id() { return (unsigned)__builtin_amdgcn_s_getreg((3 << 11) | 20) & 0xFu; }
#define XB_SPIN(cond, bar) do { unsigned _sp = 0; while (cond) { __builtin_amdgcn_s_sleep(1); \
    if ((++_sp & 255u) == 0u) { if (xb_ld(&(bar)[XB_TMO])) break; if (_sp > XB_SPIN_CAP) { atomicAdd(&(bar)[XB_TMO], 1u); break; } } } } while (0)
struct XcdBarrier { unsigned* bar; unsigned x; volatile LAS unsigned* st; };
__device__ __forceinline__ XcdBarrier xcd_barrier_post(unsigned* bar, volatile LAS unsigned* st, bool t0) {
    XcdBarrier b; b.bar = bar; b.x = xb_xcc_id(); b.st = st;
    if (t0) (void)xb_add(&bar[XB_XCNT(b.x)], 1u);
    return b;
}
__device__ __forceinline__ void xcd_barrier_complete(unsigned* bar, unsigned x, unsigned& nloc, unsigned& nx) {
    const unsigned G = gridDim.x * gridDim.y * gridDim.z;
    unsigned sum, cnt, mine, sp = 0u;
    for (;;) {
        sum = 0u; cnt = 0u; mine = 0u;
#pragma unroll
        for (unsigned j = 0; j < 16; ++j) { const unsigned c = xb_ld(&bar[XB_XCNT(j)]); sum += c; cnt += (c > 0u) ? 1u : 0u; mine = (j == x) ? c : mine; }
        if (sum == G) break;
        __builtin_amdgcn_s_sleep(1);
        if ((++sp & 255u) == 0u) { if (xb_ld(&bar[XB_TMO])) break; if (sp > XB_SPIN_CAP) { atomicAdd(&bar[XB_TMO], 1u); break; } }
    }
    nloc = mine > 0u ? mine : 1u; nx = cnt > 0u ? cnt : 1u;
}
__device__ __forceinline__ void xcd_barrier(const XcdBarrier& b, bool t0) {
    asm volatile("s_waitcnt vmcnt(0)" ::: "memory");
    __syncthreads();
    if (t0) {
        unsigned* bar = b.bar;
        __builtin_amdgcn_s_waitcnt(0);
        unsigned nloc = b.st[0], nx = b.st[1];
        if (nloc == 0u) { xcd_barrier_complete(bar, b.x, nloc, nx); b.st[0] = nloc; b.st[1] = nx; }
        const unsigned old = xb_add(&bar[XB_XSUB(b.x)], 1u);
        const unsigned gen = old / nloc;
        if (old + 1u == (gen + 1u) * nloc) {
            __builtin_amdgcn_fence(__ATOMIC_RELEASE, "agent");
            asm volatile("s_waitcnt vmcnt(0)" ::: "memory");
            const unsigned og = xb_add(&bar[XB_TOP], 1u);
            const unsigned tg = og / nx; const bool lastx = (og + 1u == (tg + 1u) * nx);
            asm volatile("buffer_inv sc1" ::: "memory");
            if (lastx) xb_add(&bar[XB_TOPGEN], 1u);
            else XB_SPIN(xb_ld(&bar[XB_TOPGEN]) == tg, bar);
            asm volatile("s_waitcnt vmcnt(0)" ::: "memory");
        } else {
            asm volatile("buffer_inv sc1" ::: "memory");
            XB_SPIN(xb_ld(&bar[XB_TOPGEN]) == gen, bar);
            asm volatile("s_waitcnt vmcnt(0)" ::: "memory");
        }
    }
    __syncthreads();
}

__device__ __forceinline__ int fresh_lane() { int l; asm volatile("v_mbcnt_lo_u32_b32 %0, -1, 0\n\tv_mbcnt_hi_u32_b32 %0, -1, %0" : "=v"(l)); return l; }
struct Args { const float* in[15]; float* out; unsigned char* ws; int ph_lo, ph_hi, li, pad; };
struct Frame { LAS unsigned char* lds; int tid, lane, wave, G, gw, NGW; };

template <int CTRL, int ROWMASK> __device__ __forceinline__ float dpp_mov(float v) { return __int_as_float(__builtin_amdgcn_update_dpp(0, __float_as_int(v), CTRL, ROWMASK, 0xF, false)); }
__device__ __forceinline__ float wave_sum(float v) {
    v += dpp_mov<0xB1, 0xF>(v);
    v += dpp_mov<0x4E, 0xF>(v);
    v += dpp_mov<0x141, 0xF>(v);
    v += dpp_mov<0x140, 0xF>(v);
    v += dpp_mov<0x142, 0xA>(v);
    v += dpp_mov<0x143, 0xC>(v);
    return __int_as_float(__builtin_amdgcn_readlane(__float_as_int(v), 63));
}
__device__ __forceinline__ void unpack8(v4u v, float* o) {
    o[0] = __uint_as_float(v.x << 16); o[1] = __uint_as_float(v.x & 0xffff0000u); o[2] = __uint_as_float(v.y << 16); o[3] = __uint_as_float(v.y & 0xffff0000u);
    o[4] = __uint_as_float(v.z << 16); o[5] = __uint_as_float(v.z & 0xffff0000u); o[6] = __uint_as_float(v.w << 16); o[7] = __uint_as_float(v.w & 0xffff0000u);
}
__device__ __forceinline__ v4u pack8(const float* o) { v4u v; v.x = pk2(o[0], o[1]); v.y = pk2(o[2], o[3]); v.z = pk2(o[4], o[5]); v.w = pk2(o[6], o[7]); return v; }

template <bool NT = false>
__device__ __forceinline__ void tr_load_tile(const float* W, int ldw, int k0, int n0s, LAS float* scr, int lane, float wsc) {
    const int g = lane & 7, kr = lane >> 3; f32x4 wv[8];
    const float* wp = W + (size_t)(k0 + kr) * ldw + n0s + 4 * g;
#pragma unroll
    for (int i = 0; i < 8; ++i) wv[i] = NT ? __builtin_nontemporal_load((const GAS f32x4*)(wp + (size_t)(8 * i) * ldw)) : *(const GAS f32x4*)(wp + (size_t)(8 * i) * ldw);
#pragma unroll
    for (int i = 0; i < 8; ++i) *(LAS f32x4*)(scr + (8 * i + kr) * 32 + 4 * (g ^ i)) = wv[i] * wsc;
    LDS_WAIT(); asm volatile("" ::: "memory");
}
__device__ __forceinline__ void tr_item(const float* W, int ldw, int k0, int n0s, bf16* WT, int K, int n0d, LAS float* scr, int lane, float wsc = 1.f) {
    tr_load_tile(W, ldw, k0, n0s, scr, lane, wsc);
    const int c = lane & 7;
#pragma unroll
    for (int j = 0; j < 4; ++j) { const int n = (lane >> 3) + 8 * j; const LAS float* s = scr + (8 * c) * 32 + 4 * ((n >> 2) ^ c) + (n & 3);
        v4u o; o.x = pk2(s[0 * 32], s[1 * 32]); o.y = pk2(s[2 * 32], s[3 * 32]); o.z = pk2(s[4 * 32], s[5 * 32]); o.w = pk2(s[6 * 32], s[7 * 32]);
        *(GAS v4u*)(WT + (size_t)(n0d + n) * K + k0 + 8 * c) = o; }
    LDS_WAIT(); asm volatile("" ::: "memory");
}
template <bool NT = false>
__device__ __forceinline__ void tr_item8(const float* W, int ldw, int k0, int n0s, unsigned char* WT, int K, int n0d, LAS float* scr, int lane) {
    typedef unsigned u32x2 __attribute__((ext_vector_type(2)));
    tr_load_tile<NT>(W, ldw, k0, n0s, scr, lane, 32.f);
    const int c = lane & 7;
#pragma unroll
    for (int j = 0; j < 4; ++j) { const int n = (lane >> 3) + 8 * j; const LAS float* s = scr + (8 * c) * 32 + 4 * ((n >> 2) ^ c) + (n & 3);
        int w0 = 0, w1 = 0;
        w0 = __builtin_amdgcn_cvt_pk_fp8_f32(s[0 * 32], s[1 * 32], w0, false); w0 = __builtin_amdgcn_cvt_pk_fp8_f32(s[2 * 32], s[3 * 32], w0, true);
        w1 = __builtin_amdgcn_cvt_pk_fp8_f32(s[4 * 32], s[5 * 32], w1, false); w1 = __builtin_amdgcn_cvt_pk_fp8_f32(s[6 * 32], s[7 * 32], w1, true);
        *(GAS u32x2*)(WT + (size_t)(n0d + n) * K + k0 + 8 * c) = (u32x2){(unsigned)w0, (unsigned)w1}; }
    LDS_WAIT(); asm volatile("" ::: "memory");
}
__device__ __forceinline__ void conv_expert_mat8(const Frame& F, const float* Wl, unsigned char* WTl) {
    LAS float* scr = (LAS float*)(F.lds + F.wave * 16384);
    constexpr int PER_E = 16 * 32, NIT = NE * PER_E;
    for (int it = F.gw; it < NIT; it += F.NGW) {
        const int e = it / PER_E, q = it % PER_E, kb = q / 32, nb = q % 32;
        tr_item8(Wl + (size_t)e * D * D, D, 64 * kb, 32 * nb, WTl + (size_t)e * D * D, D, 32 * nb, scr, F.lane);
    }
}
constexpr int CQ_NEXP = 3 * NE * 16 * 32 / 16;
constexpr int CQ_NCH = CQ_NEXP + (16 * 96 + 16 * 32) / 16;
template <bool NT = false>
__device__ __forceinline__ void conv_chunk8(const Frame& F, const float* wg, const float* wu, const float* wd, unsigned char* dst  , int chunk) {
    LAS float* scr = (LAS float*)(F.lds + F.wave * 16384);
#pragma unroll 1
    for (int j = 0; j < 2; ++j) {
        const int it = 16 * chunk + 8 * j + F.wave, mat = it >> 13, r = it & 8191, e = r >> 9, q = r & 511, kb = q >> 5, nb = q & 31;
        const float* W = (mat == 0 ? wg : mat == 1 ? wu : wd) + (size_t)e * D * D;
        tr_item8<NT>(W, D, 64 * kb, 32 * nb, dst + (size_t)mat * (16 * MiB) + (size_t)e * D * D, D, 32 * nb, scr, F.lane);
    }
}
__device__ __forceinline__ void conv_chunk_proj(const Frame& F, const float* w_in1, const float* w_out1, bf16* WinT1, bf16* WoutT1, int chunk) {
    LAS float* scr = (LAS float*)(F.lds + F.wave * 16384);
#pragma unroll 1
    for (int j = 0; j < 2; ++j) { const int it = 16 * chunk + 8 * j + F.wave;
        if (it < 16 * 96) { const int kb = it / 96, nb = it % 96, n0d = 32 * nb, pn = n0d >> 8, bj = (n0d >> 7) & 1, c0 = n0d & 127;
            const int n0s = pn < 6 ? 256 * pn + 64 * (c0 >> 5) + 32 * bj : n0d;
            tr_item(w_in1, NPROJ, 64 * kb, n0s, WinT1, D, n0d, scr, F.lane, (pn < 3 || pn == 9) ? C2 : 1.f); }
        else { const int r = it - 16 * 96, kb = r / 32, nb = r % 32;
            tr_item(w_out1, D, 64 * kb, 32 * nb, WoutT1, D, 32 * nb, scr, F.lane); } }
}
__device__ __forceinline__ void conv_pull(const Frame& F, const float* wg, const float* wu, const float* wd, unsigned char* dst, int* cq, int n,
                                          const float* w_in1, const float* w_out1, bf16* WinT1, bf16* WoutT1) {
    LAS int* mb = (LAS int*)(F.lds + MISC_OFF + 64);
    const bool t0 = F.tid == 0;
    __syncthreads();
    if (t0) { if (n > 1) { const int a2 = atomicAdd(cq, 2); mb[0] = a2; mb[1] = a2 + 1; } else { mb[0] = n > 0 ? atomicAdd(cq, 1) : CQ_NCH; mb[1] = CQ_NCH; } }
    __syncthreads();
    int cur = mb[0], nxt = mb[1];
#pragma unroll 1
    for (int i = 0; cur < CQ_NCH; ++i) {
        int fut = CQ_NCH; if (t0 && i + 2 < n) fut = atomicAdd(cq, 1);
        if (cur < CQ_NEXP) conv_chunk8(F, wg, wu, wd, dst, cur); else conv_chunk_proj(F, w_in1, w_out1, WinT1, WoutT1, cur - CQ_NEXP);
        if (t0) mb[2 + (i & 1)] = fut;
        __syncthreads();
        cur = nxt; nxt = mb[2 + (i & 1)];
    }
    __syncthreads();
}
__device__ __forceinline__ void conv_expert_mat(const Frame& F, const float* Wl, bf16* WTl) {
    LAS float* scr = (LAS float*)(F.lds + F.wave * 16384);
    constexpr int PER_E = 16 * 32, NIT = NE * PER_E;
    for (int it = F.gw; it < NIT; it += F.NGW) {
        const int e = it / PER_E, q = it % PER_E, kb = q / 32, nb = q % 32;
        tr_item(Wl + (size_t)e * D * D, D, 64 * kb, 32 * nb, WTl + (size_t)e * D * D, D, 32 * nb, scr, F.lane);
    }
}
__device__ __forceinline__ void p_prologue(const Frame& F, const float* x, const float* w_in, const float* w_out, bf16* WinT, bf16* WoutT, bf16* H0, bf16* H1, const float* bf0, float* logf, float* dummyf) {
    LAS float* scr = (LAS float*)(F.lds + F.wave * 16384);
    for (int it = F.gw; it < (MOE_FP8_L1 ? 1 : 2) * 16 * 96; it += F.NGW) {
        const int l = it / (16 * 96), r = it % (16 * 96), kb = r / 96, nb = r % 96, n0d = 32 * nb, pn = n0d >> 8, bj = (n0d >> 7) & 1, c0 = n0d & 127;
        const int n0s = pn < 6 ? 256 * pn + 64 * (c0 >> 5) + 32 * bj : n0d;
        tr_item(w_in + (size_t)l * D * NPROJ, NPROJ, 64 * kb, n0s, WinT + (size_t)l * NZ * D, D, n0d, scr, F.lane, (pn < 3 || pn == 9) ? C2 : 1.f);
    }
    for (int it = F.gw; it < (MOE_FP8_L1 ? 1 : 2) * 16 * 32; it += F.NGW) {
        const int l = it / (16 * 32), r = it % (16 * 32), kb = r / 32, nb = r % 32;
        tr_item(w_out + (size_t)l * D * D, D, 64 * kb, 32 * nb, WoutT + (size_t)l * D * D, D, 32 * nb, scr, F.lane);
    }
    __syncthreads();
    { LAS float* wfl = (LAS float*)F.lds;
      for (int k = F.tid; k < D; k += 512) { const f32x4 w = *(const GAS f32x4*)(w_in + (size_t)k * NPROJ + NZ); wfl[k] = w.x; wfl[D + k] = w.y; wfl[2 * D + k] = w.z; wfl[3 * D + k] = w.w; }
      __syncthreads();
      f32x4 xv[2][4];
#define PRO_LOAD(slot_, m_) do { const GAS f32x4* xr_ = (const GAS f32x4*)(x + (size_t)(m_) * D) + F.lane; _Pragma("unroll") for (int j = 0; j < 4; ++j) xv[slot_][j] = xr_[64 * j]; } while (0)
#define PRO_ROW(slot_, m_) do { const int mm_ = (m_); GAS unsigned long long* o8 = (GAS unsigned long long*)(H0 + (size_t)mm_ * D) + F.lane; \
        float acc[4] = {0.f, 0.f, 0.f, 0.f}; f32x4 cv[4]; _Pragma("unroll") for (int j = 0; j < 4; ++j) cv[j] = xv[slot_][j]; \
        { const int mn_ = mm_ + 2 * F.NGW < T ? mm_ + 2 * F.NGW : mm_; PRO_LOAD(slot_, mn_); } \
        _Pragma("unroll") for (int j = 0; j < 4; ++j) { const f32x4 v = cv[j]; o8[64 * j] = (unsigned long long)pk2(v.x, v.y) | ((unsigned long long)pk2(v.z, v.w) << 32); \
            _Pragma("unroll") for (int q = 0; q < 4; ++q) { const f32x4 w = *(const LAS f32x4*)(wfl + q * D + 4 * F.lane + 256 * j); acc[q] += v.x * w.x + v.y * w.y + v.z * w.z + v.w * w.w; } } \
        _Pragma("unroll") for (int q = 0; q < 4; ++q) acc[q] = wave_sum(acc[q]); \
        { const int l3_ = F.lane & 3; const float z = (l3_ == 0 ? acc[0] : l3_ == 1 ? acc[1] : l3_ == 2 ? acc[2] : acc[3]) + bfv; \
          float* lp_ = F.lane < 4 ? logf + (size_t)mm_ * 4 + F.lane : dummyf + (size_t)F.gw * 64 + F.lane; \
          *lp_ = fminf(z, 0.f) - log1pf(expf(-fabsf(z))); } } while (0)
      const float bfv = bf0[F.lane & 3];
      { const int m1 = F.gw + F.NGW < T ? F.gw + F.NGW : F.gw; PRO_LOAD(0, F.gw);
      { float* dm_ = dummyf + (size_t)F.gw * 64 + F.lane;
      _Pragma("unroll") for (int i_ = 0; i_ < (5); ++i_) { *dm_ = 0.f; asm volatile("" ::: "memory"); } }
        PRO_LOAD(1, m1);
      { float* dm_ = dummyf + (size_t)F.gw * 64 + F.lane;
      _Pragma("unroll") for (int i_ = 0; i_ < (5); ++i_) { *dm_ = 0.f; asm volatile("" ::: "memory"); } }
      }
      for (int m = F.gw; m < T; m += 2 * F.NGW) {
        asm volatile("" ::: "memory");
        PRO_ROW(0, m);
        PRO_ROW(1, m + F.NGW < T ? m + F.NGW : m);
      }
#undef PRO_ROW
#undef PRO_LOAD
    }
    if (blockIdx.x == 0) { for (int i = F.tid; i < D; i += 512) { H0[(size_t)T * D + i] = 0; H1[(size_t)T * D + i] = 0; } }
    __syncthreads();
}
__device__ __forceinline__ void p_merge(const Frame& F, const bf16* OP, const float* ML, const bf16* OF, const float* gd, const float* gf, bf16* YN) {
    typedef float f32x2 __attribute__((ext_vector_type(2)));
    const int lane = F.lane; const bool dil = lane < 48; const int h = dil ? lane >> 2 : 0;
    v4u ro[6]; f32x2 rm[3];
    float gq[16];
    { const float* gp = dil ? gd + lane * 16 : gf + (lane - 48) * 16;
#pragma unroll
      for (int j4 = 0; j4 < 4; ++j4) { const f32x4 g4 = *(const GAS f32x4*)(gp + 4 * j4); gq[4 * j4] = g4[0]; gq[4 * j4 + 1] = g4[1]; gq[4 * j4 + 2] = g4[2]; gq[4 * j4 + 3] = g4[3]; } }
#define MG_LOAD(t_) do { _Pragma("unroll") for (int br = 0; br < 3; ++br) { \
            rm[br] = *(const GAS f32x2*)(ML + ((((size_t)br * T + ((t_) & ~15)) * 12) + (size_t)h * 16 + ((t_) & 15)) * 2); \
            const bf16* op_ = dil ? OP + ((size_t)br * T + (t_)) * 768 + lane * 16 : OF + (size_t)(t_) * 256 + (lane - 48) * 16; \
            ro[2 * br] = *(const GAS v4u*)op_; ro[2 * br + 1] = *(const GAS v4u*)(op_ + 8); } } while (0)
    MG_LOAD(F.gw < T ? F.gw : 0);
    for (int t = F.gw; t < T; t += F.NGW) {
        asm volatile("" ::: "memory");
        float v[16];
        {
            const float M = fmaxf(rm[0].x, fmaxf(rm[1].x, rm[2].x));
            float w[3], ws = 0.f;
#pragma unroll
            for (int br = 0; br < 3; ++br) { w[br] = rm[br].y * exp2f(rm[br].x - M); ws += w[br]; }
            const float iws = 1.f / ws;
            if (!dil) { w[0] = ws; w[1] = 0.f; w[2] = 0.f; }
#pragma unroll
            for (int j = 0; j < 16; ++j) v[j] = 0.f;
#pragma unroll
            for (int br = 0; br < 3; ++br) { float a[16]; unpack8(ro[2 * br], a); unpack8(ro[2 * br + 1], a + 8); const float wn = w[br] * iws;
#pragma unroll
                for (int j = 0; j < 16; ++j) v[j] += wn * a[j]; }
        }
        { const int tn = t + F.NGW < T ? t + F.NGW : t; MG_LOAD(tn); }
        float ss = 0.f;
#pragma unroll
        for (int j = 0; j < 16; ++j) ss += v[j] * v[j];
        const float sd = wave_sum(dil ? ss : 0.f), sf = wave_sum(dil ? 0.f : ss);
        const float r = dil ? rsqrtf(sd / 768.f + RMS_EPS) : rsqrtf(sf / 256.f + RMS_EPS);
        float o[16];
#pragma unroll
        for (int j = 0; j < 16; ++j) o[j] = v[j] * r * gq[j];
        *(GAS v4u*)(YN + (size_t)t * D + lane * 16) = pack8(o); *(GAS v4u*)(YN + (size_t)t * D + lane * 16 + 8) = pack8(o + 8);
    }
#undef MG_LOAD
}
template <bool H1Q8>
__device__ __forceinline__ void p_ln1(const Frame& F, const bf16* H0, const bf16* Y1, const float* g, const float* bb, const float* w_router, const float* b_router,
                                      bf16* H1, int* toke, float* tokg, int* histg, unsigned char* H1q, float* dummyf) {
    typedef short bf16x8_t __attribute__((ext_vector_type(8))); typedef float f32x2_t __attribute__((ext_vector_type(2)));
    LAS unsigned char* wfr = F.lds; LAS int* hist = (LAS int*)(F.lds + 65536);
    LAS f32x2_t* part = (LAS f32x2_t*)(F.lds + 65536 + 256); LAS f32x4* racc = (LAS f32x4*)(F.lds + 65536 + 4096);
    for (int it = F.tid; it < 2048; it += 512) { const int s = it >> 6, l = it & 63; float w[8];
#pragma unroll
        for (int j = 0; j < 8; ++j) w[j] = w_router[(32 * s + 8 * (l >> 4) + j) * NE + (l & 15)];
        v4u hi4, lo4;
        hi4.x = pk2(w[0], w[1]); hi4.y = pk2(w[2], w[3]); hi4.z = pk2(w[4], w[5]); hi4.w = pk2(w[6], w[7]);
        lo4.x = pk2(w[0] - __uint_as_float(hi4.x << 16), w[1] - __uint_as_float(hi4.x & 0xffff0000u)); lo4.y = pk2(w[2] - __uint_as_float(hi4.y << 16), w[3] - __uint_as_float(hi4.y & 0xffff0000u));
        lo4.z = pk2(w[4] - __uint_as_float(hi4.z << 16), w[5] - __uint_as_float(hi4.z & 0xffff0000u)); lo4.w = pk2(w[6] - __uint_as_float(hi4.w << 16), w[7] - __uint_as_float(hi4.w & 0xffff0000u));
        *(LAS v4u*)(wfr + it * 16) = hi4; *(LAS v4u*)(wfr + 32768 + it * 16) = lo4; }
    LAS float* gl = (LAS float*)(F.lds + 65536 + 4096 + 65536); LAS float* bl_ = (LAS float*)(F.lds + MISC_OFF + 256);
    static_assert(65536 + 4096 + 65536 + 4096 <= MISC_OFF && MISC_OFF + 256 + 4096 <= LDS_BYTES, "LN1 LDS map");
    for (int k = F.tid; k < D / 4; k += 512) { *(LAS f32x4*)(gl + 4 * k) = *(const GAS f32x4*)(g + 4 * k); *(LAS f32x4*)(bl_ + 4 * k) = *(const GAS f32x4*)(bb + 4 * k); }
    if (F.tid < NE) hist[F.tid] = 0;
    if (H1Q8 && blockIdx.x == 0 && F.tid < 256) ((GAS unsigned*)(H1q + (size_t)T * D))[F.tid] = 0u;
    __syncthreads();
    const int lane = F.lane, tk = lane & 15, kq = lane >> 4, w8 = F.wave;
    const int col0 = 128 * w8 + 8 * kq;
    LAS const float* gp = gl + col0; LAS const float* bp = bl_ + col0;
    v4u lh[4], ly[4];
#define LN1_LOAD(it_) do { const size_t ro_ = (size_t)(blockIdx.x * 128 + 16 * (it_) + tk) * D + col0; \
        _Pragma("unroll") for (int i = 0; i < 4; ++i) { lh[i] = *(const GAS v4u*)(H0 + ro_ + 32 * i); ly[i] = *(const GAS v4u*)(Y1 + ro_ + 32 * i); } } while (0)
    LN1_LOAD(0);
    { float* dm_ = dummyf + (size_t)F.gw * 64 + F.lane;
      _Pragma("unroll") for (int i_ = 0; i_ < (H1Q8 ? 8 : 4); ++i_) { *dm_ = 0.f; asm volatile("" ::: "memory"); } }
    for (int it = 0; it < 8; ++it) {
        asm volatile("" ::: "memory");
        const int t = blockIdx.x * 128 + 16 * it + tk;
        float u[32]; float sum = 0.f, sq = 0.f;
#pragma unroll
        for (int i = 0; i < 4; ++i) { float a[8], y[8]; unpack8(lh[i], a); unpack8(ly[i], y);
#pragma unroll
            for (int j = 0; j < 8; ++j) { const float x = ALPHA * a[j] + y[j]; u[8 * i + j] = x; sum += x; sq += x * x; } }
        LN1_LOAD(it + 1 < 8 ? it + 1 : it);
        sum = pg8::rows4_sum(sum); sq = pg8::rows4_sum(sq);
        LAS f32x2_t* pp = part + (it & 1) * 128;
        if (lane < 16) pp[w8 * 16 + tk] = (f32x2_t){sum, sq};
        asm volatile("s_waitcnt lgkmcnt(0)\n\ts_barrier" ::: "memory");
        float ts = 0.f, tq = 0.f;
#pragma unroll
        for (int w = 0; w < 8; ++w) { const f32x2_t p = pp[w * 16 + tk]; ts += p.x; tq += p.y; }
        const float mu = ts * (1.f / D); const float rstd = rsqrtf(fmaxf(tq * (1.f / D) - mu * mu, 0.f) + LN_EPS);
        f32x4 acc = {0.f, 0.f, 0.f, 0.f};
#pragma unroll
        for (int i = 0; i < 4; ++i) {
            const f32x4 g0 = *(LAS const f32x4*)(gp + 32 * i), g1 = *(LAS const f32x4*)(gp + 32 * i + 4), b0 = *(LAS const f32x4*)(bp + 32 * i), b1 = *(LAS const f32x4*)(bp + 32 * i + 4);
            float v[8];
#pragma unroll
            for (int j = 0; j < 8; ++j) v[j] = (u[8 * i + j] - mu) * rstd * (j < 4 ? g0[j] : g1[j - 4]) + (j < 4 ? b0[j] : b1[j - 4]);
            v4u hi4, lo4;
            hi4.x = pk2(v[0], v[1]); hi4.y = pk2(v[2], v[3]); hi4.z = pk2(v[4], v[5]); hi4.w = pk2(v[6], v[7]);
            lo4.x = pk2(v[0] - __uint_as_float(hi4.x << 16), v[1] - __uint_as_float(hi4.x & 0xffff0000u)); lo4.y = pk2(v[2] - __uint_as_float(hi4.y << 16), v[3] - __uint_as_float(hi4.y & 0xffff0000u));
            lo4.z = pk2(v[4] - __uint_as_float(hi4.z << 16), v[5] - __uint_as_float(hi4.z & 0xffff0000u)); lo4.w = pk2(v[6] - __uint_as_float(hi4.w << 16), v[7] - __uint_as_float(hi4.w & 0xffff0000u));
            *(GAS v4u*)(H1 + (size_t)t * D + col0 + 32 * i) = hi4;
            if constexpr (H1Q8) { typedef unsigned u32x2_ __attribute__((ext_vector_type(2))); int w0 = 0, w1 = 0;
                w0 = __builtin_amdgcn_cvt_pk_fp8_f32(v[0], v[1], w0, false); w0 = __builtin_amdgcn_cvt_pk_fp8_f32(v[2], v[3], w0, true);
                w1 = __builtin_amdgcn_cvt_pk_fp8_f32(v[4], v[5], w1, false); w1 = __builtin_amdgcn_cvt_pk_fp8_f32(v[6], v[7], w1, true);
                *(GAS u32x2_*)(H1q + (size_t)t * D + col0 + 32 * i) = (u32x2_){(unsigned)w0, (unsigned)w1}; }
            const bf16x8_t ah = __builtin_bit_cast(bf16x8_t, hi4), al = __builtin_bit_cast(bf16x8_t, lo4);
            const int s = 4 * w8 + i;
            const bf16x8_t bh = *(const LAS bf16x8_t*)(wfr + (s * 64 + lane) * 16), bl = *(const LAS bf16x8_t*)(wfr + 32768 + (s * 64 + lane) * 16);
            acc = __builtin_amdgcn_mfma_f32_16x16x32_bf16(ah, bh, acc, 0, 0, 0);
            acc = __builtin_amdgcn_mfma_f32_16x16x32_bf16(ah, bl, acc, 0, 0, 0);
            acc = __builtin_amdgcn_mfma_f32_16x16x32_bf16(al, bh, acc, 0, 0, 0); }
        racc[(it * 8 + w8) * 64 + lane] = acc;
    }
    __syncthreads();
    {
        const int it = w8;
        f32x4 lg = racc[(it * 8) * 64 + lane];
#pragma unroll
        for (int w = 1; w < 8; ++w) lg += racc[(it * 8 + w) * 64 + lane];
        const int e = lane & 15; const float bre = b_router[e];
#pragma unroll
        for (int r = 0; r < 4; ++r) {
            const int tt = blockIdx.x * 128 + 16 * it + 4 * kq + r;
            const float x = lg[r] + bre;
#define QX1(v_) dpp_mov<0xB1, 0xF>(v_)
#define QX2(v_) dpp_mov<0x4E, 0xF>(v_)
#define QX3(v_) dpp_mov<0x1B, 0xF>(v_)
#define HM8(v_) dpp_mov<0x141, 0xF>(v_)
#define RM16(v_) dpp_mov<0x140, 0xF>(v_)
            float m = x; m = fmaxf(m, QX1(m)); m = fmaxf(m, QX2(m)); m = fmaxf(m, HM8(m)); m = fmaxf(m, RM16(m));
            float p = expf(x - m); float ss = p; ss += QX1(ss); ss += QX2(ss); ss += HM8(ss); ss += RM16(ss);
            p /= ss;
            const float o1 = QX1(p), o2 = QX2(p), o3 = QX3(p);
            float gs = fmaxf(p + o1, fmaxf(p + o2, p + o3)); gs = fmaxf(gs, QX1(gs)); gs = fmaxf(gs, QX2(gs));
            float bv = gs; int bg = (lane >> 2) & 3;
            { const float ov = HM8(bv); const int og = __float_as_int(HM8(__int_as_float(bg))); if (ov > bv || (ov == bv && og < bg)) { bv = ov; bg = og; } }
            { const float ov = RM16(bv); const int og = __float_as_int(RM16(__int_as_float(bg))); if (ov > bv || (ov == bv && og < bg)) { bv = ov; bg = og; } }
            const int me = lane & 3;
            const int rank = ((o1 > p || (o1 == p && (me ^ 1) < me)) ? 1 : 0) + ((o2 > p || (o2 == p && (me ^ 2) < me)) ? 1 : 0) + ((o3 > p || (o3 == p && (me ^ 3) < me)) ? 1 : 0);
            float v12 = rank < 2 ? p : 0.f; v12 += QX1(v12); v12 += QX2(v12);
#undef QX1
#undef QX2
#undef QX3
#undef HM8
#undef RM16
            if (((lane >> 2) & 3) == bg && rank < 2) { toke[tt * 2 + rank] = e; tokg[tt * 2 + rank] = p / v12; atomicAdd((int*)&hist[e], 1); }
        }
    }
#undef LN1_LOAD
    __syncthreads();
    { const int t2 = F.wave * 64 + fresh_lane(); if (t2 < NE) histg[blockIdx.x * NE + t2] = hist[t2]; }
    __syncthreads();
}
__device__ __forceinline__ void p_route(const Frame& F, const int* toke, int* rt, int* rowtok, int* slot) {
    LAS int* hs = (LAS int*)(F.lds);
    LAS int* part = hs + 256 * 17;
    LAS int* sh = part + 512;
    const int b = blockIdx.x, tid = F.tid, lane = F.lane;
    if (tid < 256) { const int* hp = rt + 16384 + tid * NE;
#pragma unroll
        for (int q = 0; q < 4; ++q) { const int4 c = *(const int4*)(hp + 4 * q); hs[tid * 17 + 4 * q] = c.x; hs[tid * 17 + 4 * q + 1] = c.y; hs[tid * 17 + 4 * q + 2] = c.z; hs[tid * 17 + 4 * q + 3] = c.w; } }
    const int my_e = tid < 256 ? (toke[b * 256 + tid] & (NE - 1)) : -1;
    __syncthreads();
    if (tid < 256) { const int e = tid & 15, p = tid >> 4; int tot = 0, pre = 0;
#pragma unroll
        for (int k = 0; k < 16; ++k) { const int blk = 16 * p + k; const int c = hs[blk * 17 + e]; tot += c; pre += blk < b ? c : 0; }
        part[e * 16 + p] = tot; part[256 + e * 16 + p] = pre; }
    int rank_w = 0;
    if (tid < 256) {
#pragma unroll
        for (int e = 0; e < NE; ++e) { const unsigned long long m = __ballot(my_e == e); if (my_e == e) rank_w = __popcll(m & ((1ull << lane) - 1ull)); if (lane == 0) sh[64 + F.wave * 16 + e] = __popcll(m); } }
    __syncthreads();
    if (tid < 16) { int tot = 0, pre = 0;
#pragma unroll
        for (int p = 0; p < 16; ++p) { tot += part[tid * 16 + p]; pre += part[256 + tid * 16 + p]; }
        sh[tid] = tot; sh[16 + tid] = pre;
        const int pc = (tot + RB - 1) / RB * RB; int sc = pc;
        sc += __builtin_amdgcn_update_dpp(0, sc, 0x111, 0xF, 0xF, true); sc += __builtin_amdgcn_update_dpp(0, sc, 0x112, 0xF, 0xF, true);
        sc += __builtin_amdgcn_update_dpp(0, sc, 0x114, 0xF, 0xF, true); sc += __builtin_amdgcn_update_dpp(0, sc, 0x118, 0xF, 0xF, true);
        sh[32 + tid] = sc - pc; if (tid == 15) sh[48] = sc; }
    __syncthreads();
    if (tid < 256) { int r = rank_w; for (int w = 0; w < F.wave; ++w) r += sh[64 + w * 16 + my_e];
        const int pos = sh[32 + my_e] + sh[16 + my_e] + r; rowtok[pos] = b * 128 + (tid >> 1); slot[b * 256 + tid] = pos; }
    if (b < NE) { const int st = sh[32 + b] + sh[b], en = sh[32 + b] + (sh[b] + RB - 1) / RB * RB; for (int r = st + tid; r < en; r += 512) rowtok[r] = T; }
    if (b == 0) { if (tid == 0) rt[48] = sh[48];
        for (int e = 0; e < NE; ++e) { const int st = sh[32 + e] / RB, en = (sh[32 + e] + (sh[e] + RB - 1) / RB * RB) / RB; for (int r = st + tid; r < en; r += 512) rt[64 + r] = e; } }
    __syncthreads();
}
template <bool YB8, bool LASTL>
__device__ __forceinline__ void p_ln2(const Frame& F, const bf16* H1, const bf16* YB, const int* slot, const float* tokg, const float* g, const float* bb, bf16* H0, float* outf,
                                      const float* w_in_next, const float* bf_next, float* logf, float* dummyf) {
    const int lane = F.lane;
    LAS float* wfl = (LAS float*)F.lds;
    if (!LASTL) { for (int k = F.tid; k < D; k += 512) { const f32x4 w = *(const GAS f32x4*)(w_in_next + (size_t)k * NPROJ + NZ); const int kp = ((k >> 2) & 3) * 256 + (k >> 4) * 4 + (k & 3);
            wfl[kp] = w.x; wfl[D + kp] = w.y; wfl[2 * D + kp] = w.z; wfl[3 * D + kp] = w.w; }
        __syncthreads(); }
    const int nrow = (T - F.gw + F.NGW - 1) / F.NGW;
    int sl0 = 0, sl1 = 0; float gg0 = 0.f, gg1 = 0.f;
    if (lane < nrow) { const int tk = F.gw + lane * F.NGW; sl0 = slot[tk * 2]; sl1 = slot[tk * 2 + 1]; gg0 = tokg[tk * 2]; gg1 = tokg[tk * 2 + 1]; }
    float gv[16], bv[16];
#pragma unroll
    for (int j4 = 0; j4 < 4; ++j4) { const f32x4 g4 = *(const GAS f32x4*)(g + lane * 16 + 4 * j4), b4 = *(const GAS f32x4*)(bb + lane * 16 + 4 * j4);
#pragma unroll
        for (int jj = 0; jj < 4; ++jj) { gv[4 * j4 + jj] = g4[jj]; bv[4 * j4 + jj] = b4[jj]; } }
    const float bfn = LASTL ? 0.f : bf_next[lane & 3];
    v4u rh0, rh1, ra0, ra1, rb0, rb1;
#define LN2_LOAD(k_) do { const int tt_ = F.gw + (k_) * F.NGW; const int s0_ = __builtin_amdgcn_readlane(sl0, (k_)), s1_ = __builtin_amdgcn_readlane(sl1, (k_)); \
        const bf16* hp_ = H1 + (size_t)tt_ * D + lane * 16; rh0 = *(const GAS v4u*)hp_; rh1 = *(const GAS v4u*)(hp_ + 8); \
        if (YB8) { ra0 = *(const GAS v4u*)((const unsigned char*)YB + (size_t)s0_ * D + lane * 16); rb0 = *(const GAS v4u*)((const unsigned char*)YB + (size_t)s1_ * D + lane * 16); } \
        else { const bf16* p0_ = YB + (size_t)s0_ * D + lane * 16; const bf16* p1_ = YB + (size_t)s1_ * D + lane * 16; \
               ra0 = *(const GAS v4u*)p0_; ra1 = *(const GAS v4u*)(p0_ + 8); rb0 = *(const GAS v4u*)p1_; rb1 = *(const GAS v4u*)(p1_ + 8); } } while (0)
    LN2_LOAD(0);
    { float* dm_ = dummyf + (size_t)F.gw * 64 + F.lane;
      _Pragma("unroll") for (int i_ = 0; i_ < (LASTL ? 4 : 3); ++i_) { *dm_ = 0.f; asm volatile("" ::: "memory"); } }
    for (int k = 0; k < nrow; ++k) {
        asm volatile("" ::: "memory");
        const int t = F.gw + k * F.NGW; const float g0 = __int_as_float(__builtin_amdgcn_readlane(__float_as_int(gg0), k)), g1 = __int_as_float(__builtin_amdgcn_readlane(__float_as_int(gg1), k));
        float v[16]; float s = 0.f;
        { float a[16], y0[16], y1[16];
          unpack8(rh0, a); unpack8(rh1, a + 8);
          if (YB8) { typedef float f32x2_ __attribute__((ext_vector_type(2)));
#pragma unroll
              for (int q = 0; q < 4; ++q) { const int wa = (int)(q == 0 ? ra0.x : q == 1 ? ra0.y : q == 2 ? ra0.z : ra0.w), wb = (int)(q == 0 ? rb0.x : q == 1 ? rb0.y : q == 2 ? rb0.z : rb0.w);
                  const f32x2_ a0 = __builtin_amdgcn_cvt_pk_f32_fp8(wa, false), a1 = __builtin_amdgcn_cvt_pk_f32_fp8(wa, true), b0 = __builtin_amdgcn_cvt_pk_f32_fp8(wb, false), b1 = __builtin_amdgcn_cvt_pk_f32_fp8(wb, true);
                  y0[4 * q] = a0.x * 0.125f; y0[4 * q + 1] = a0.y * 0.125f; y0[4 * q + 2] = a1.x * 0.125f; y0[4 * q + 3] = a1.y * 0.125f;
                  y1[4 * q] = b0.x * 0.125f; y1[4 * q + 1] = b0.y * 0.125f; y1[4 * q + 2] = b1.x * 0.125f; y1[4 * q + 3] = b1.y * 0.125f; } }
          else { unpack8(ra0, y0); unpack8(ra1, y0 + 8); unpack8(rb0, y1); unpack8(rb1, y1 + 8); }
          { const int kn = k + 1 < nrow ? k + 1 : k; LN2_LOAD(kn); }
#pragma unroll
          for (int j = 0; j < 16; ++j) { v[j] = ALPHA * a[j] + (g0 * y0[j] + g1 * y1[j]); s += v[j]; } }
        const float mu = wave_sum(s) * (1.f / D); float q = 0.f;
#pragma unroll
        for (int j = 0; j < 16; ++j) { v[j] -= mu; q += v[j] * v[j]; }
        const float rstd = rsqrtf(wave_sum(q) * (1.f / D) + LN_EPS);
#pragma unroll
        for (int j = 0; j < 16; ++j) v[j] = v[j] * rstd * gv[j] + bv[j];
        if constexpr (LASTL) { GAS f32x4* o = (GAS f32x4*)(outf + (size_t)t * D + lane * 16);
#pragma unroll
            for (int j = 0; j < 4; ++j) __builtin_nontemporal_store((f32x4){v[4 * j], v[4 * j + 1], v[4 * j + 2], v[4 * j + 3]}, (f32x4*)(o + j)); }
        else { *(GAS v4u*)(H0 + (size_t)t * D + lane * 16) = pack8(v); *(GAS v4u*)(H0 + (size_t)t * D + lane * 16 + 8) = pack8(v + 8);
            float acc[4] = {0.f, 0.f, 0.f, 0.f};
#pragma unroll
            for (int q = 0; q < 4; ++q)
#pragma unroll
                for (int j4 = 0; j4 < 4; ++j4) { const f32x4 w = *(const LAS f32x4*)(wfl + q * D + j4 * 256 + lane * 4); acc[q] += v[4 * j4] * w.x + v[4 * j4 + 1] * w.y + v[4 * j4 + 2] * w.z + v[4 * j4 + 3] * w.w; }
#pragma unroll
            for (int q = 0; q < 4; ++q) acc[q] = wave_sum(acc[q]);
            { const int l3 = lane & 3; const float z = (l3 == 0 ? acc[0] : l3 == 1 ? acc[1] : l3 == 2 ? acc[2] : acc[3]) + bfn;
              float* lp = lane < 4 ? logf + (size_t)t * 4 + lane : dummyf + (size_t)F.gw * 64 + lane;
              *lp = fminf(z, 0.f) - log1pf(expf(-fabsf(z))); } }
    }
#undef LN2_LOAD
    __syncthreads();
}
#ifndef DUPMASK
#define DUPMASK 0u
#endif
__device__ __forceinline__ void p_dil(const Frame& F, int vcu, const bf16* Z, bf16* OP, float* ML, int* dqc, const float* kmaxd, int* dummy) {
    char* shm = (char*)F.lds;
    att::u32x4 kv[12], qv[4]; att::bf16x8 qr[4];
    const int xcd_ = vcu >> 5;
    LAS int* dq = (LAS int*)(F.lds + att::L_WSF);
    const bool t0 = F.tid == 0;
    if (t0) { const int a2 = atomicAdd(dqc, 2); dq[0] = a2; dq[1] = a2 + 1; }
    __syncthreads();
    int ucur = dq[0], unxt = dq[1];
#define DIL_UNIT(q_) ((xcd_ + 8 * ((q_) / 48)) * 48 + (q_) % 48)
    att::DilU cu = att::dil_decode(DIL_UNIT(ucur < 576 ? ucur : 0)), nu = cu;
    float bkc = kmaxd[cu.b * HD_DIL + cu.h], bkn = bkc;
    if (ucur < 576) { att::dil_issue(cu, Z, F.tid, kv, qv);
        int* dm = dummy + blockIdx.x * 512 + F.tid;
#pragma unroll
        for (int k = 0; k < 5; ++k) { dm[0] = k; asm volatile("" ::: "memory"); } }
    for (int i = 0; ucur < 576; ++i) {
        att::dil_commit(shm, F.tid, kv, qv);
        asm volatile("s_waitcnt lgkmcnt(0)\n\ts_barrier" ::: "memory");
        int ufut; const int one_ = 1;
        if (t0) asm volatile("global_atomic_add %0, %1, %2, off sc0" : "=v"(ufut) : "v"(dqc), "v"(one_) : "memory");
        att::dil_qfrag(shm, F.tid, qr);
        if (unxt < 576) { nu = att::dil_decode(DIL_UNIT(unxt)); bkn = kmaxd[nu.b * HD_DIL + nu.h]; att::dil_issue(nu, Z, F.tid, kv, qv); }
        att::dil_compute(cu, qr, OP, ML, shm, F.tid, bkc, [&]() { if (t0) { asm volatile("s_waitcnt vmcnt(0)" : "+v"(ufut) :: "memory"); dq[2 + (i & 1)] = ufut; } });
        asm volatile("s_waitcnt lgkmcnt(0)\n\ts_barrier" ::: "memory");
        cu = nu; bkc = bkn; ucur = unxt; unxt = dq[2 + (i & 1)];
    }
#undef DIL_UNIT
}
__device__ __forceinline__ void p_fox(const Frame& F, int vcu, const bf16* Z, const float* logf, bf16* OF, const float* kmax) {
    char* shm = (char*)F.lds;
    const int bh = vcu >> 3, sidx = vcu & 7, b = bh >> 2, h = bh & 3;
    att::fox_bias(b, h, 256 * (16 - sidx), logf, shm, F.tid);
    const float bk2 = kmax[(b * HD_FOX + h) * 2] + kmax[(b * HD_FOX + h) * 2 + 1];
    att::fox_unit(b, h, 15 - sidx, Z, OF, shm, F.tid, bk2);
    att::fox_unit(b, h, sidx, Z, OF, shm, F.tid, bk2);
}

#ifndef GU_ALIGN
#define GU_ALIGN true
#endif
#ifndef IP_ALIGN
#define IP_ALIGN true
#endif
enum { PH_PRO = 0, PH_LOGF = 1, PH_INPROJ, PH_ATTN, PH_MERGE, PH_OUTPROJ, PH_LN1, PH_ROUTE, PH_GATEUP, PH_DOWN, PH_LN2, PH_PER_LAYER = 10, PH_TOTAL = 1 + 2 * PH_PER_LAYER };

__global__ void __launch_bounds__(NWAVES * 64, 2) mk_fwd(Args args) {
    extern __shared__ __attribute__((aligned(16))) unsigned char lds[];
    LAS unsigned char* const ldsb = (LAS unsigned char*)lds;
    typedef const __attribute__((address_space(4))) Args* KArgs;
    const int wave_s = __builtin_amdgcn_readfirstlane(threadIdx.x >> 6);
    const int bx = blockIdx.x; const int vcu = (gridDim.x % 8 == 0) ? (bx % 8) * ((int)gridDim.x / 8) + bx / 8 : bx;
#define MKF() KArgs ap = (KArgs)__builtin_amdgcn_kernarg_segment_ptr(); asm volatile("" : "+s"(ap)); Frame F; { F.lds = ldsb; F.lane = fresh_lane(); F.wave = wave_s; F.tid = wave_s * 64 + F.lane; \
                         F.G = gridDim.x; F.gw = vcu * NWAVES + F.wave; F.NGW = F.G * NWAVES; }
#define W_(off) (ap->ws + (off))
#define P_Z ((bf16*)W_(WS_Z))
#define P_OP ((bf16*)W_(WS_OP))
#define P_H0 ((bf16*)W_(WS_H0))
#define P_H1 ((bf16*)W_(WS_H1))
#define P_WINT ((bf16*)W_(WS_WIO))
#define P_WOUTT ((bf16*)W_(WS_WIO + 12 * MiB))
#define P_WGT ((bf16*)((unsigned char*)ap->out + OUT_WG))
#define P_WUT ((bf16*)((unsigned char*)ap->out + OUT_WU))
#define P_WDT ((bf16*)((unsigned char*)ap->out + OUT_WD))
#define P_WG8L(l_) ((unsigned char*)ap->out + (size_t)(l_) * OUT_WL + OUT_WG8)
#define P_WU8L(l_) ((unsigned char*)ap->out + (size_t)(l_) * OUT_WL + OUT_WU8)
#define P_WD8L(l_) ((unsigned char*)ap->out + (size_t)(l_) * OUT_WL + OUT_WD8)
#define P_WG8 P_WG8L(0)
#define P_WU8 P_WU8L(0)
#define P_WD8 P_WD8L(0)
#define P_H1Q ((unsigned char*)W_(WS_H1Q))
#define CONV_PULL(n_) conv_pull(F, ap->in[10] + (size_t)NE * D * D, ap->in[11] + (size_t)NE * D * D, ap->in[12] + (size_t)NE * D * D, P_WG8L(1), (int*)P_SM(SM_CTL) + CW_CQ, (n_), \
        ap->in[1] + (size_t)D * NPROJ, ap->in[5] + (size_t)D * D, P_WINT + (size_t)NZ * D, P_WOUTT + (size_t)D * D)
#ifndef CQ_GU
#define CQ_GU 4
#endif
#ifndef CQ_DN
#define CQ_DN 5
#endif
#define CONV_EXPERTS(l_) do { const size_t eo_ = (size_t)(l_) * NE * D * D; \
        if (((l_) == 0) ? MOE_FP8_L0 : MOE_FP8_L1) { conv_expert_mat8(F, ap->in[10] + eo_, P_WG8); conv_expert_mat8(F, ap->in[11] + eo_, P_WU8); conv_expert_mat8(F, ap->in[12] + eo_, P_WD8); } \
        else { conv_expert_mat(F, ap->in[10] + eo_, P_WGT); conv_expert_mat(F, ap->in[11] + eo_, P_WUT); conv_expert_mat(F, ap->in[12] + eo_, P_WDT); } } while (0)
#define P_SM(off) (W_(WS_SM + (off)))
#define P_LOGF ((float*)P_SM(SM_LOGF))
#define P_TOKE ((int*)P_SM(SM_TOKE))
#define P_TOKG ((float*)P_SM(SM_TOKG))
#define P_SLOT ((int*)P_SM(SM_SLOT))
#define P_ROWTOK ((int*)P_SM(SM_ROWTOK))
#define P_RT ((int*)P_SM(SM_RT))
#define P_WF ((float*)P_SM(SM_WF))
#define P_ML ((float*)P_SM(SM_ML))
#define P_OF ((bf16*)P_SM(SM_OF))
    volatile LAS unsigned* MISC = (volatile LAS unsigned*)(ldsb + MISC_OFF);
    { const int l_ = fresh_lane(); if (wave_s == 0) MISC[l_] = 0u; }
    __syncthreads();
    unsigned* ctl; { KArgs ap = (KArgs)__builtin_amdgcn_kernarg_segment_ptr(); ctl = (unsigned*)P_SM(SM_CTL); }
    const bool multi = (args.ph_hi - args.ph_lo) > 1;
    XcdBarrier bar; bar.bar = ctl + CW_BAR; bar.x = 0; bar.st = nullptr;
#define T0_() (wave_s == 0 && fresh_lane() == 0)
    if (multi) bar = xcd_barrier_post(ctl + CW_BAR, MISC + 8, T0_());
    const int lo = args.ph_lo, hi = args.ph_hi;
#ifndef PHMASK
#define PHMASK 0xFFFFFFFFu
#endif
#define IN(k) (((PHMASK >> ((k) > 10 ? (k) - 10 : (k))) & 1u) && lo <= (k) && (k) < hi)
#define REP(k) for (int rep_ = 0; rep_ < (((DUPMASK >> (k)) & 1u) ? 2 : 1); ++rep_)
#define SEAM(k) do { if (IN(k) && IN((k) + 1)) { xcd_barrier(bar, T0_()); if ((DUPMASK >> 13) & 1u) xcd_barrier(bar, T0_()); } } while (0)
    if (IN(PH_PRO)) REP(PH_PRO) { MKF();
        p_prologue(F, ap->in[0], ap->in[1], ap->in[5], P_WINT, P_WOUTT, P_H0, P_H1, ap->in[2], P_LOGF, (float*)P_SM(SM_CUM));
        if (!MOE_FP8_L0) CONV_EXPERTS(0);
    } SEAM(PH_PRO);
    auto layer = [&](auto lc) __attribute__((always_inline)) {
        constexpr int l = decltype(lc)::value; constexpr int base = l * PH_PER_LAYER; constexpr bool F8 = (l == 0) ? MOE_FP8_L0 : MOE_FP8_L1;
        if (IN(base + PH_INPROJ)) REP(PH_INPROJ) { MKF();
            pg8::Gemm g{P_H0, P_WINT + (size_t)l * NZ * D, nullptr, nullptr};
            pg8::TileOrder So; So.init(T / 256, NZ / 256, F.G, bx);
            pg8::EpiInproj E{P_Z, (unsigned*)P_SM(SM_CTL) + CW_KMAX + l * 64, (unsigned*)P_SM(SM_CTL) + CW_KMAXD + l * 96};
            pg8::gemm_phase<pg8::EpiInproj, 128L * D * 2, 256, false, false, false, IP_ALIGN>(F.lds, g, So, E, F.tid);
        } SEAM(base + PH_INPROJ);
        if (IN(base + PH_ATTN)) {
            if constexpr (l == 0 && MOE_FP8_L0) { MKF(); if (((vcu >> 3) & 1) == 0) {
#pragma unroll 1
                for (int j = 0; j < 6; ++j) conv_chunk8<true>(F, ap->in[10], ap->in[11], ap->in[12], P_WG8L(0), bx * 6 + j);
                __syncthreads(); } }
            asm volatile("" ::: "memory");
            { MKF(); p_fox(F, vcu, P_Z, P_LOGF, P_OF, (const float*)((unsigned*)P_SM(SM_CTL) + CW_KMAX + l * 64)); }
            asm volatile("" ::: "memory");
            if constexpr (l == 0 && MOE_FP8_L0) { MKF(); if (((vcu >> 3) & 1) != 0) { __syncthreads();
#pragma unroll 1
                for (int j = 0; j < 6; ++j) conv_chunk8<true>(F, ap->in[10], ap->in[11], ap->in[12], P_WG8L(0), bx * 6 + j);
                __syncthreads(); } }
            asm volatile("" ::: "memory");
            { MKF(); p_dil(F, vcu, P_Z, P_OP, P_ML, (int*)P_SM(SM_CTL) + CW_DQ + (l * 8 + (vcu >> 5)) * 64, (const float*)((unsigned*)P_SM(SM_CTL) + CW_KMAXD + l * 96), (int*)P_SM(SM_CUM)); } } SEAM(base + PH_ATTN);
        if (IN(base + PH_MERGE)) REP(PH_MERGE) { MKF(); p_merge(F, P_OP, P_ML, P_OF, ap->in[3] + l * 768, ap->in[4] + l * 256, P_H1  ); } SEAM(base + PH_MERGE);
        if (IN(base + PH_OUTPROJ)) REP(PH_OUTPROJ) { MKF();
            pg8::Gemm g{P_H1  , P_WOUTT + (size_t)l * D * D, nullptr, nullptr};
            pg8::TileOrder So; So.init(T / 256, D / 256, F.G, bx);
            pg8::EpiPlain E{P_Z  , D, 1.f};
            pg8::gemm_phase<pg8::EpiPlain, 128L * D * 2, 256, false, false>(F.lds, g, So, E, F.tid);
        } SEAM(base + PH_OUTPROJ);
        if (IN(base + PH_LN1)) REP(PH_LN1) { MKF(); p_ln1<F8>(F, P_H0, P_Z  , ap->in[6] + l * D, ap->in[7] + l * D, ap->in[8], ap->in[9], P_H1, P_TOKE, P_TOKG, P_RT + 16384, F8 ? P_H1Q : nullptr, (float*)P_SM(SM_CUM)); } SEAM(base + PH_LN1);
        if (IN(base + PH_ROUTE)) REP(PH_ROUTE) { MKF(); p_route(F, P_TOKE, P_RT, P_ROWTOK, P_SLOT); } SEAM(base + PH_ROUTE);
        if (IN(base + PH_GATEUP)) REP(PH_GATEUP) { MKF();
            const int nblk = __builtin_amdgcn_readfirstlane(P_RT[48]) / RB;
            pg8::TileOrder So; So.init(nblk, 8, F.G, bx);
            if constexpr (F8) { pg8::Gemm g{P_H1Q, P_WG8L(l), P_ROWTOK, P_RT + 64}; pg8::EpiSwiglu8 E{(unsigned char*)P_Z  };
                pg8::gemm_phase<pg8::EpiSwiglu8, (long)(OUT_WU8 - OUT_WG8), 128, true, true, true, GU_ALIGN>(F.lds, g, So, E, F.tid);
                if constexpr (l == 0 && MOE_FP8_L1) { asm volatile("" ::: "memory"); const int nwg = (__builtin_amdgcn_readfirstlane(P_RT[48]) / RB) * 8, mine = nwg > bx ? (nwg - bx + F.G - 1) / F.G : 0, mx = (nwg + F.G - 1) / F.G;
                    if (mx > mine) CONV_PULL((mx - mine) * CQ_GU); } }
            else { pg8::Gemm g{P_H1, P_WGT, P_ROWTOK, P_RT + 64}; pg8::EpiSwiglu E{P_Z  };
                pg8::gemm_phase<pg8::EpiSwiglu, (long)(OUT_WU - OUT_WG), 128, true, true>(F.lds, g, So, E, F.tid); }
        } SEAM(base + PH_GATEUP);
        if (IN(base + PH_DOWN)) REP(PH_DOWN) { MKF();
            const int nblk = __builtin_amdgcn_readfirstlane(P_RT[48]) / RB;
            pg8::TileOrder So; So.init(nblk, 4, F.G, bx);
            if constexpr (F8) { pg8::Gemm g{P_Z  , P_WD8L(l), nullptr, P_RT + 64}; pg8::EpiPlain8 E{(unsigned char*)P_OP  , 8.f / 32.f};
                pg8::gemm_phase<pg8::EpiPlain8, 128L * D, 256, false, true, true>(F.lds, g, So, E, F.tid);
                if constexpr (l == 0 && MOE_FP8_L1) { asm volatile("" ::: "memory"); const int nwg = (__builtin_amdgcn_readfirstlane(P_RT[48]) / RB) * 4, mine = nwg > bx ? (nwg - bx + F.G - 1) / F.G : 0, mx = (nwg + F.G - 1) / F.G;
                    if (mx > mine) CONV_PULL((mx - mine) * CQ_DN); } }
            else { pg8::Gemm g{P_Z  , P_WDT, nullptr, P_RT + 64}; pg8::EpiPlain E{P_OP  , D, 1.f};
                pg8::gemm_phase<pg8::EpiPlain, 128L * D * 2, 256, false, true>(F.lds, g, So, E, F.tid); }
        } SEAM(base + PH_DOWN);
        if (IN(base + PH_LN2)) REP(PH_LN2) { MKF();
            p_ln2<F8, (l == DEPTH - 1)>(F, P_H1, P_OP  , P_SLOT, P_TOKG, ap->in[13] + l * D, ap->in[14] + l * D, P_H0, l == DEPTH - 1 ? ap->out : nullptr,
                  ap->in[1] + (size_t)(l + 1 < DEPTH ? l + 1 : 0) * D * NPROJ, ap->in[2] + (l + 1 < DEPTH ? l + 1 : 0) * 4, P_LOGF, (float*)P_SM(SM_CUM));
            if constexpr (l + 1 < DEPTH) { if constexpr (MOE_FP8_L1) CONV_PULL(0x7fffffff); else CONV_EXPERTS(l + 1); }
        } SEAM(base + PH_LN2);
    };
    layer(std::integral_constant<int, 0>{});
    layer(std::integral_constant<int, 1>{});
    if (lo == 100) { MKF(); CONV_PULL(0x7fffffff); }
#undef IN
#undef SEAM
}


extern "C" void kernel_launch(void* const* d_in, const int* in_sizes, int n_in, void* d_out, int out_size, void* d_ws, size_t ws_size, hipStream_t stream) {
    static int grid = 0;
    if (grid == 0) {
        if (n_in != 15 || out_size != T * D || ws_size < WS_END) { fprintf(stderr, "kernel_launch: unexpected shapes / workspace (%d inputs, out %d, ws %zu < %zu)\n", n_in, out_size, ws_size, (size_t)WS_END); grid = -1; return; }
        int dev = 0, cus = 0;
        if (hipGetDevice(&dev) != hipSuccess || hipDeviceGetAttribute(&cus, hipDeviceAttributeMultiprocessorCount, dev) != hipSuccess) { grid = -1; return; }
        if (hipFuncSetAttribute((const void*)mk_fwd, hipFuncAttributeMaxDynamicSharedMemorySize, LDS_BYTES) != hipSuccess) { grid = -1; return; }
        int per_cu = 0; (void)hipOccupancyMaxActiveBlocksPerMultiprocessor(&per_cu, (const void*)mk_fwd, NWAVES * 64, LDS_BYTES); (void)hipGetLastError();
        if (cus != 256 || per_cu < 1) { fprintf(stderr, "kernel_launch: needs 256 CUs with one resident workgroup each (cus %d, per_cu %d)\n", cus, per_cu); grid = -1; return; }
        grid = 256;
    }
    if (grid < 0) return;
    unsigned char* sm = (unsigned char*)d_ws + WS_SM;
    (void)hipMemsetAsync(sm + SM_CTL, 0, 1 * MiB, stream);
    Args a{};
    for (int i = 0; i < 15; ++i) a.in[i] = (const float*)d_in[i];
    a.out = (float*)d_out; a.ws = (unsigned char*)d_ws;
#if MK_DEBUG
    debug_forward(a, d_in, d_out, d_ws, stream, grid);
#else
    a.ph_lo = 0; a.ph_hi = PH_TOTAL; a.li = 0;
    hipLaunchKernelGGL(mk_fwd, dim3(grid), dim3(NWAVES * 64), LDS_BYTES, stream, a);
#endif
}
```
